# Optimizing an MI355X kernel written in HIP

```python
import jax, jax.numpy as jnp
from jax import lax
import numpy as np

D_MODEL = 1024
BATCH = 8
SEQ = 4096
DEPTH = 1

CHUNK = 64
D_MIX = D_MODEL
D_A = D_MIX // 2
D_B = D_MIX - D_A
SGU_BLOCK = 128
SGU_GROUPS = 4
SGU_DIM = D_A // SGU_GROUPS
N_HEADS_B = 4
HEAD_DIM_B = D_B // N_HEADS_B
IDX_HEADS = 8
IDX_DIM = 64
MAX_TOPK = 256
QBLOCK = 128
NUM_BUCKETS = 32
MAX_DISTANCE = 128
D_FF = ((8 * D_MODEL // 3 + 255) // 256) * 256
EPS = 1e-6
SPLITS = (D_A, D_A, D_B, D_B, D_B, IDX_HEADS * IDX_DIM, IDX_DIM, IDX_HEADS)
D_IN = sum(SPLITS)

kernel_name = "hybrid_sgu_dsa_sandwich_block"


def _rmsnorm(x, g):
    xf = x.astype(jnp.float32)
    y = xf * lax.rsqrt(jnp.mean(xf * xf, axis=-1, keepdims=True) + EPS)
    return (y * g.astype(jnp.float32)).astype(x.dtype)


def _layernorm(x, g, b):
    xf = x.astype(jnp.float32)
    mu = jnp.mean(xf, axis=-1, keepdims=True)
    var = jnp.mean(jnp.square(xf - mu), axis=-1, keepdims=True)
    y = (xf - mu) * lax.rsqrt(var + EPS)
    return (y * g.astype(jnp.float32) + b.astype(jnp.float32)).astype(x.dtype)


def _t5_bucket(rel):
    nb = NUM_BUCKETS // 2
    ret = (rel > 0).astype(jnp.int32) * nb
    n = jnp.abs(rel)
    max_exact = nb // 2
    nf = jnp.maximum(n, 1).astype(jnp.float32)
    large = max_exact + (jnp.log(nf / max_exact) / np.float32(np.log(MAX_DISTANCE / max_exact))
                         * (nb - max_exact)).astype(jnp.int32)
    large = jnp.minimum(large, nb - 1)
    return ret + jnp.where(n < max_exact, n, large)


def _spatial_gating(u, v, ln_g, ln_b, w_s, b_s):
    B, S, _ = v.shape
    vn = _layernorm(v, ln_g, ln_b)
    vb = vn.reshape(B, S // SGU_BLOCK, SGU_BLOCK, SGU_GROUPS, SGU_DIM)
    pos_chunk = jnp.arange(SGU_BLOCK) // CHUNK
    mask = pos_chunk[None, :] <= pos_chunk[:, None]
    w = jnp.where(mask[None], w_s, jnp.zeros_like(w_s))
    mixed = jnp.einsum('gij,bcjgd->bcigd', w, vb) + jnp.transpose(b_s)[None, None, :, :, None]
    return u * mixed.reshape(B, S, D_A)


def _dsa_attention(q, k, v, iq, ik, iw, rel_bias):
    B, S, H, Dh = q.shape
    top_k = min(MAX_TOPK, S // 4)
    nb = S // QBLOCK
    s_chunk = jnp.arange(S) // CHUNK
    ikf = ik.astype(jnp.float32)

    def to_blocks(a):
        return jnp.moveaxis(a.reshape((B, nb, QBLOCK) + a.shape[2:]), 1, 0)

    def one_block(args):
        qb, iqb, iwb, blk = args
        t = blk * QBLOCK + jnp.arange(QBLOCK)
        t_chunk = t // CHUNK
        dots = jax.nn.relu(jnp.einsum('bqhd,bsd->bqhs', iqb.astype(jnp.float32), ikf)
                           * np.float32(IDX_DIM ** -0.5))
        score = jnp.einsum('bqh,bqhs->bqs', iwb.astype(jnp.float32) * np.float32(IDX_HEADS ** -0.5), dots)
        visible = s_chunk[None, :] <= t_chunk[:, None]
        score = jnp.where(visible[None], score, -jnp.inf)
        _, idx = lax.top_k(score, top_k)
        valid = (idx // CHUNK) <= t_chunk[None, :, None]
        k_sel = jax.vmap(lambda kb, ib: kb[ib])(k, idx)
        v_sel = jax.vmap(lambda vb, ib: vb[ib])(v, idx)
        bias = jnp.take(rel_bias, _t5_bucket(idx - t[None, :, None]), axis=0)
        logits = (jnp.einsum('bqhd,bqkhd->bqhk', qb, k_sel).astype(jnp.float32) * np.float32(Dh ** -0.5)
                  + jnp.moveaxis(bias, -1, 2).astype(jnp.float32))
        logits = jnp.where(valid[:, :, None, :], logits, -jnp.inf)
        p = jax.nn.softmax(logits, axis=-1).astype(v.dtype)
        return jnp.einsum('bqhk,bqkhd->bqhd', p, v_sel)

    out = lax.map(one_block, (to_blocks(q), to_blocks(iq), to_blocks(iw), jnp.arange(nb)))
    return jnp.moveaxis(out, 0, 1).reshape(B, S, H * Dh)


def setup_inputs(seed: int = 0) -> dict:
    key = jax.random.key(seed)
    ks = jax.random.split(key, 16)
    f32 = jnp.float32

    def gain(k, shape):
        return jnp.ones(shape, f32) + 0.01 * jax.random.normal(k, shape, f32)

    return {
        "x": jax.random.normal(ks[0], (BATCH, SEQ, D_MODEL), f32),
        "g_pre_mix": gain(ks[1], (DEPTH, D_MODEL)),
        "w_in": jax.random.normal(ks[2], (DEPTH, D_MODEL, D_IN), f32) * D_MODEL ** -0.5,
        "sgu_ln_g": gain(ks[3], (DEPTH, D_A)),
        "sgu_ln_b": 0.01 * jax.random.normal(ks[4], (DEPTH, D_A), f32),
        "sgu_w": jax.random.normal(ks[5], (DEPTH, SGU_GROUPS, SGU_BLOCK, SGU_BLOCK), f32) * SGU_BLOCK ** -0.5,
        "sgu_b": gain(ks[6], (DEPTH, SGU_GROUPS, SGU_BLOCK)),
        "rel_bias": 0.5 * jax.random.normal(ks[7], (NUM_BUCKETS, N_HEADS_B), f32),
        "w_o": jax.random.normal(ks[8], (DEPTH, D_MIX, D_MODEL), f32) * D_MIX ** -0.5,
        "g_post_mix": gain(ks[9], (DEPTH, D_MODEL)),
        "g_pre_ffn": gain(ks[10], (DEPTH, D_MODEL)),
        "w_gate": jax.random.normal(ks[11], (DEPTH, D_MODEL, D_FF), f32) * D_MODEL ** -0.5,
        "w_up": jax.random.normal(ks[12], (DEPTH, D_MODEL, D_FF), f32) * D_MODEL ** -0.5,
        "w_down": jax.random.normal(ks[13], (DEPTH, D_FF, D_MODEL), f32) * D_FF ** -0.5,
        "g_post_ffn": gain(ks[14], (DEPTH, D_MODEL)),
    }


def reference(x, g_pre_mix, w_in, sgu_ln_g, sgu_ln_b, sgu_w, sgu_b, rel_bias,
              w_o, g_post_mix, g_pre_ffn, w_gate, w_up, w_down, g_post_ffn):
    B, S, _ = x.shape
    offsets = np.cumsum(SPLITS)[:-1].tolist()
    for l in range(DEPTH):
        h = _rmsnorm(x, g_pre_mix[l])
        proj = h @ w_in[l]
        a_u, a_v, q, k, v, iq, ik, iw = jnp.split(proj, offsets, axis=-1)
        out_a = _spatial_gating(a_u, a_v, sgu_ln_g[l], sgu_ln_b[l], sgu_w[l], sgu_b[l])
        out_b = _dsa_attention(
            q.reshape(B, S, N_HEADS_B, HEAD_DIM_B),
            k.reshape(B, S, N_HEADS_B, HEAD_DIM_B),
            v.reshape(B, S, N_HEADS_B, HEAD_DIM_B),
            iq.reshape(B, S, IDX_HEADS, IDX_DIM), ik, iw, rel_bias)
        mix = jnp.concatenate([out_a, out_b], axis=-1) @ w_o[l]
        x = x + _rmsnorm(mix, g_post_mix[l])
        h = _rmsnorm(x, g_pre_ffn[l])
        f = (jax.nn.silu(h @ w_gate[l]) * (h @ w_up[l])) @ w_down[l]
        x = x + _rmsnorm(f, g_post_ffn[l])
    return x
```

```cpp
#include <hip/hip_runtime.h>
#include <cstdio>
#include <cstdint>

namespace nv {
constexpr int B = 8, S = 4096, D = 1024, T = B * S;
constexpr int DA = 512, DIN = 3144, DFF = 2816;
constexpr int C_AU = 0, C_AV = 512, C_Q = 1024, C_K = 1536, C_V = 2048, C_IQ = 2560, C_IK = 3072, C_IW = 3136;
constexpr float EPS = 1e-6f;

__device__ __forceinline__ float wave_sum(float v) {
#pragma unroll
    for (int o = 32; o > 0; o >>= 1) v += __shfl_xor(v, o);
    return v;
}
__device__ __forceinline__ float wave_max(float v) {
#pragma unroll
    for (int o = 32; o > 0; o >>= 1) v = fmaxf(v, __shfl_xor(v, o));
    return v;
}

__global__ void k_rowrstd(const float* __restrict__ X, int ncols, int ld, float* __restrict__ rstd, int nrows) {
    const int row = blockIdx.x * 4 + (threadIdx.x >> 6), lane = threadIdx.x & 63;
    if (row >= nrows) return;
    const float* x = X + (size_t)row * ld;
    float s = 0.f;
    for (int c = lane; c < ncols; c += 64) { const float v = x[c]; s += v * v; }
    s = wave_sum(s);
    if (lane == 0) rstd[row] = rsqrtf(s / (float)ncols + EPS);
}

template <bool DUAL>
__global__ void __launch_bounds__(256) k_gemm(const float* __restrict__ A, int lda, const float* __restrict__ rs, const float* __restrict__ gk,
                                              const float* __restrict__ W0, const float* __restrict__ W1, int ldw,
                                              float* __restrict__ C, int ldc, int M, int N, int K) {
    __shared__ float As[16][65];
    __shared__ float Bs0[16][64];
    __shared__ float Bs1[DUAL ? 16 : 1][64];
    const int tid = threadIdx.x, tx = tid & 15, ty = tid >> 4;
    const int m0 = blockIdx.y * 64, n0 = blockIdx.x * 64;
    float acc0[4][4] = {}, acc1[4][4] = {};
    for (int k0 = 0; k0 < K; k0 += 16) {
        {
            const int r = tid >> 2, kk = (tid & 3) * 4;
            const int m = m0 + r;
            float4 v = make_float4(0.f, 0.f, 0.f, 0.f);
            if (m < M) v = *(const float4*)(A + (size_t)m * lda + k0 + kk);
            const float sc = (rs && m < M) ? rs[m] : 1.f;
            float g0 = 1.f, g1 = 1.f, g2 = 1.f, g3 = 1.f;
            if (gk) { g0 = gk[k0 + kk]; g1 = gk[k0 + kk + 1]; g2 = gk[k0 + kk + 2]; g3 = gk[k0 + kk + 3]; }
            As[kk + 0][r] = v.x * sc * g0; As[kk + 1][r] = v.y * sc * g1; As[kk + 2][r] = v.z * sc * g2; As[kk + 3][r] = v.w * sc * g3;
        }
        {
            const int kk = tid >> 4, nn = (tid & 15) * 4;
#pragma unroll
            for (int j = 0; j < 4; ++j) {
                const int n = n0 + nn + j;
                Bs0[kk][nn + j] = (n < N) ? W0[(size_t)(k0 + kk) * ldw + n] : 0.f;
                if (DUAL) Bs1[kk][nn + j] = (n < N) ? W1[(size_t)(k0 + kk) * ldw + n] : 0.f;
            }
        }
        __syncthreads();
#pragma unroll
        for (int kk = 0; kk < 16; ++kk) {
            float a[4], b0[4], b1[4];
#pragma unroll
            for (int i = 0; i < 4; ++i) a[i] = As[kk][ty * 4 + i];
#pragma unroll
            for (int j = 0; j < 4; ++j) { b0[j] = Bs0[kk][tx * 4 + j]; if (DUAL) b1[j] = Bs1[kk][tx * 4 + j]; }
#pragma unroll
            for (int i = 0; i < 4; ++i)
#pragma unroll
                for (int j = 0; j < 4; ++j) { acc0[i][j] += a[i] * b0[j]; if (DUAL) acc1[i][j] += a[i] * b1[j]; }
        }
        __syncthreads();
    }
#pragma unroll
    for (int i = 0; i < 4; ++i) {
        const int m = m0 + ty * 4 + i; if (m >= M) continue;
#pragma unroll
        for (int j = 0; j < 4; ++j) {
            const int n = n0 + tx * 4 + j; if (n >= N) continue;
            float v = acc0[i][j];
            if (DUAL) { const float g = v; v = g / (1.f + __expf(-g)) * acc1[i][j]; }
            C[(size_t)m * ldc + n] = v;
        }
    }
}

__global__ void __launch_bounds__(256) k_sgu(const float* __restrict__ proj, const float* __restrict__ ln_g, const float* __restrict__ ln_b,
                                             const float* __restrict__ sw, const float* __restrict__ sb, float* __restrict__ mixin) {
    __shared__ float vn[128][64];
    __shared__ float mu[128], rsd[128];
    const int blk = blockIdx.x, g = blockIdx.y, dh = blockIdx.z;
    const int tid = threadIdx.x, lane = tid & 63, w = tid >> 6;
    const size_t t0 = (size_t)blk * 128;
    for (int j = w; j < 128; j += 4) {
        const float* av = proj + (t0 + j) * DIN + C_AV;
        float s = 0.f;
        for (int c = lane; c < DA; c += 64) s += av[c];
        s = wave_sum(s);
        const float m = s / (float)DA;
        float q = 0.f;
        for (int c = lane; c < DA; c += 64) { const float d = av[c] - m; q += d * d; }
        q = wave_sum(q);
        if (lane == 0) { mu[j] = m; rsd[j] = rsqrtf(q / (float)DA + EPS); }
    }
    __syncthreads();
    for (int e = tid; e < 128 * 64; e += 256) {
        const int j = e >> 6, d = e & 63, col = g * 128 + dh * 64 + d;
        vn[j][d] = (proj[(t0 + j) * DIN + C_AV + col] - mu[j]) * rsd[j] * ln_g[col] + ln_b[col];
    }
    __syncthreads();
    const int d = tid & 63;
    for (int i = tid >> 6; i < 128; i += 4) {
        const int jmax = (i < 64) ? 64 : 128;
        const float* wr = sw + ((size_t)g * 128 + i) * 128;
        float acc = 0.f;
        for (int j = 0; j < jmax; ++j) acc += wr[j] * vn[j][d];
        acc += sb[g * 128 + i];
        const int col = g * 128 + dh * 64 + d;
        mixin[(t0 + i) * D + col] = proj[(t0 + i) * DIN + C_AU + col] * acc;
    }
}

__device__ __forceinline__ unsigned f2ord(float f) { const unsigned u = __float_as_uint(f); return (u & 0x80000000u) ? ~u : (u | 0x80000000u); }

__global__ void __launch_bounds__(256) k_select(const float* __restrict__ proj, unsigned* __restrict__ selbits) {
    __shared__ float iq[512];
    __shared__ float iw[8];
    __shared__ unsigned key[4096];
    __shared__ unsigned cnt;
    __shared__ unsigned bits[128];
    const int t = blockIdx.x, b = t / S, tp = t % S, tid = threadIdx.x;
    const int nvis = 64 * (tp / 64 + 1);
    const float* row = proj + (size_t)t * DIN;
    for (int i = tid; i < 512; i += 256) iq[i] = row[C_IQ + i];
    if (tid < 8) iw[tid] = row[C_IW + tid] * 0.35355339059327373f;
    if (tid < 128) bits[tid] = 0u;
    __syncthreads();
    if (nvis <= 256) {
        for (int s = tid; s < nvis; s += 256) atomicOr(&bits[s >> 5], 1u << (s & 31));
        __syncthreads();
        if (tid < 128) selbits[(size_t)t * 128 + tid] = bits[tid];
        return;
    }
    for (int s = tid; s < nvis; s += 256) {
        const float* ik = proj + ((size_t)b * S + s) * DIN + C_IK;
        float kv[64];
#pragma unroll
        for (int d4 = 0; d4 < 16; ++d4) { const float4 v = *(const float4*)(ik + d4 * 4); kv[d4 * 4] = v.x; kv[d4 * 4 + 1] = v.y; kv[d4 * 4 + 2] = v.z; kv[d4 * 4 + 3] = v.w; }
        float sc = 0.f;
        for (int h = 0; h < 8; ++h) {
            float dsum = 0.f;
#pragma unroll
            for (int d = 0; d < 64; ++d) dsum += iq[h * 64 + d] * kv[d];
            dsum *= 0.125f;
            sc += iw[h] * fmaxf(dsum, 0.f);
        }
        key[s] = f2ord(sc);
    }
    __syncthreads();
    unsigned Tv = 0u;
    for (int bit = 31; bit >= 0; --bit) {
        const unsigned cand = Tv | (1u << bit);
        if (tid == 0) cnt = 0u;
        __syncthreads();
        unsigned c = 0;
        for (int s = tid; s < nvis; s += 256) c += (key[s] >= cand) ? 1u : 0u;
        c = (unsigned)wave_sum((float)c);
        if ((tid & 63) == 0) atomicAdd(&cnt, c);
        __syncthreads();
        if (cnt >= 256u) Tv = cand;
        __syncthreads();
    }
    if (tid == 0) cnt = 0u;
    __syncthreads();
    {
        unsigned c = 0;
        for (int s = tid; s < nvis; s += 256) c += (key[s] > Tv) ? 1u : 0u;
        c = (unsigned)wave_sum((float)c);
        if ((tid & 63) == 0) atomicAdd(&cnt, c);
    }
    __syncthreads();
    const unsigned ngt = cnt;
    for (int s = tid; s < nvis; s += 256) if (key[s] > Tv) atomicOr(&bits[s >> 5], 1u << (s & 31));
    __syncthreads();
    if (tid == 0) {
        unsigned need = 256u - ngt;
        for (int s = 0; s < nvis && need > 0; ++s) if (key[s] == Tv) { bits[s >> 5] |= 1u << (s & 31); --need; }
    }
    __syncthreads();
    if (tid < 128) selbits[(size_t)t * 128 + tid] = bits[tid];
}

__device__ __forceinline__ int t5_bucket(int rel) {
    const int ret = rel > 0 ? 16 : 0;
    const int n = rel < 0 ? -rel : rel;
    int v;
    if (n < 8) v = n; else if (n < 12) v = 8; else if (n < 16) v = 9; else if (n < 23) v = 10; else if (n < 32) v = 11;
    else if (n < 46) v = 12; else if (n < 64) v = 13; else if (n < 91) v = 14; else v = 15;
    return ret + v;
}

__global__ void __launch_bounds__(256) k_attn(const float* __restrict__ proj, const unsigned* __restrict__ selbits, const float* __restrict__ rel_bias,
                                              float* __restrict__ mixin) {
    __shared__ int list[256];
    __shared__ int nsel;
    __shared__ float p[4][256];
    __shared__ float qs[512];
    const int t = blockIdx.x, b = t / S, tp = t % S, tid = threadIdx.x, h = tid >> 6, lane = tid & 63;
    if (tid == 0) nsel = 0;
    for (int i = tid; i < 512; i += 256) qs[i] = proj[(size_t)t * DIN + C_Q + i];
    __syncthreads();
    for (int s = tid; s < S; s += 256) {
        if ((selbits[(size_t)t * 128 + (s >> 5)] >> (s & 31)) & 1u) { const int pos = atomicAdd(&nsel, 1); if (pos < 256) list[pos] = s; }
    }
    __syncthreads();
    const int n = nsel < 256 ? nsel : 256;
    float lg[4]; float mx = -INFINITY;
#pragma unroll
    for (int jj = 0; jj < 4; ++jj) {
        const int j = lane + jj * 64;
        lg[jj] = -INFINITY;
        if (j < n) {
            const int s = list[j];
            const float* kr = proj + ((size_t)b * S + s) * DIN + C_K + h * 128;
            float dsum = 0.f;
            for (int d = 0; d < 128; d += 4) { const float4 kv = *(const float4*)(kr + d); dsum += qs[h * 128 + d] * kv.x + qs[h * 128 + d + 1] * kv.y + qs[h * 128 + d + 2] * kv.z + qs[h * 128 + d + 3] * kv.w; }
            lg[jj] = dsum * 0.08838834764831845f + rel_bias[t5_bucket(s - tp) * 4 + h];
        }
        mx = fmaxf(mx, lg[jj]);
    }
    mx = wave_max(mx);
    float sum = 0.f;
#pragma unroll
    for (int jj = 0; jj < 4; ++jj) { const int j = lane + jj * 64; const float e = (j < n) ? __expf(lg[jj] - mx) : 0.f; p[h][j] = e; sum += e; }
    sum = wave_sum(sum);
    __syncthreads();
    const float inv = 1.f / sum;
    float o0 = 0.f, o1 = 0.f;
    for (int j = 0; j < n; ++j) {
        const int s = list[j];
        const float* vr = proj + ((size_t)b * S + s) * DIN + C_V + h * 128;
        const float pj = p[h][j];
        o0 += pj * vr[lane]; o1 += pj * vr[lane + 64];
    }
    mixin[(size_t)t * D + 512 + h * 128 + lane] = o0 * inv;
    mixin[(size_t)t * D + 512 + h * 128 + lane + 64] = o1 * inv;
}

__global__ void k_resid(const float* X, const float* Z, const float* __restrict__ rs, const float* __restrict__ g,
                        float* Y, int nrows) {
    const size_t i = (size_t)blockIdx.x * 256 + threadIdx.x;
    if (i >= (size_t)nrows * D) return;
    const int m = (int)(i / D), n = (int)(i % D);
    Y[i] = X[i] + Z[i] * rs[m] * g[n];
}
}

extern "C" void kernel_launch(void* const* d_in, const int* in_sizes, int n_in, void* d_out, int out_size, void* d_ws, size_t ws_size, hipStream_t stream) {
    using namespace nv;
    const float* x = (const float*)d_in[0];
    const float* g_pre_mix = (const float*)d_in[1];
    const float* w_in = (const float*)d_in[2];
    const float* sgu_ln_g = (const float*)d_in[3];
    const float* sgu_ln_b = (const float*)d_in[4];
    const float* sgu_w = (const float*)d_in[5];
    const float* sgu_b = (const float*)d_in[6];
    const float* rel_bias = (const float*)d_in[7];
    const float* w_o = (const float*)d_in[8];
    const float* g_post_mix = (const float*)d_in[9];
    const float* g_pre_ffn = (const float*)d_in[10];
    const float* w_gate = (const float*)d_in[11];
    const float* w_up = (const float*)d_in[12];
    const float* w_down = (const float*)d_in[13];
    const float* g_post_ffn = (const float*)d_in[14];
    float* out = (float*)d_out;
    char* ws = (char*)d_ws;
    const size_t MB = 1u << 20;
    float* proj = (float*)(ws);
    float* rstd1 = (float*)(ws + 440 * MB);
    float* rstd2 = (float*)(ws + 441 * MB);
    float* rstd3 = (float*)(ws + 442 * MB);
    float* rstd4 = (float*)(ws + 443 * MB);
    unsigned* selbits = (unsigned*)(ws + 398 * MB);
    float* mixin = out;
    float* mix = (float*)(ws);
    float* x1 = (float*)(ws + 128 * MB);
    float* hmid = (float*)(ws + 256 * MB);
    float* fbuf = out;

    k_rowrstd<<<T / 4, 256, 0, stream>>>(x, D, D, rstd1, T);
    k_gemm<false><<<dim3((DIN + 63) / 64, T / 64), 256, 0, stream>>>(x, D, rstd1, g_pre_mix, w_in, nullptr, DIN, proj, DIN, T, DIN, D);
    k_sgu<<<dim3(T / 128, 4, 2), 256, 0, stream>>>(proj, sgu_ln_g, sgu_ln_b, sgu_w, sgu_b, mixin);
    k_select<<<T, 256, 0, stream>>>(proj, selbits);
    k_attn<<<T, 256, 0, stream>>>(proj, selbits, rel_bias, mixin);
    k_gemm<false><<<dim3(D / 64, T / 64), 256, 0, stream>>>(mixin, D, nullptr, nullptr, w_o, nullptr, D, mix, D, T, D, D);
    k_rowrstd<<<T / 4, 256, 0, stream>>>(mix, D, D, rstd2, T);
    k_resid<<<(unsigned)(((size_t)T * D + 255) / 256), 256, 0, stream>>>(x, mix, rstd2, g_post_mix, x1, T);
    k_rowrstd<<<T / 4, 256, 0, stream>>>(x1, D, D, rstd3, T);
    for (int half = 0; half < 2; ++half) {
        const int r0 = half * (T / 2);
        k_gemm<true><<<dim3(DFF / 64, T / 2 / 64), 256, 0, stream>>>(x1 + (size_t)r0 * D, D, rstd3 + r0, g_pre_ffn, w_gate, w_up, DFF, hmid, DFF, T / 2, DFF, D);
        k_gemm<false><<<dim3(D / 64, T / 2 / 64), 256, 0, stream>>>(hmid, DFF, nullptr, nullptr, w_down, nullptr, D, fbuf + (size_t)r0 * D, D, T / 2, D, DFF);
    }
    k_rowrstd<<<T / 4, 256, 0, stream>>>(fbuf, D, D, rstd4, T);
    k_resid<<<(unsigned)(((size_t)T * D + 255) / 256), 256, 0, stream>>>(x1, fbuf, rstd4, g_post_ffn, out, T);
}
```

```cpp
#include <hip/hip_runtime.h>
#include <cstdio>
#include <cstdint>

#ifndef MK_PER_PHASE
#define MK_PER_PHASE 1
#endif

#define LAS __attribute__((address_space(3)))
#define GAS __attribute__((address_space(1)))
typedef unsigned short bf16_t;
typedef short bf16x8 __attribute__((ext_vector_type(8)));
typedef short s16x4 __attribute__((ext_vector_type(4)));
typedef float f32x2 __attribute__((ext_vector_type(2)));
typedef float f32x4 __attribute__((ext_vector_type(4)));
typedef float f32x16 __attribute__((ext_vector_type(16)));
typedef unsigned u32x2 __attribute__((ext_vector_type(2)));
typedef unsigned u32x4 __attribute__((ext_vector_type(4)));

constexpr int NB = 8, SEQ = 4096, DM = 1024, NT = NB * SEQ;
constexpr int DA = 512, DFF = 2816, DIN = 3144, DINP = 3328;
constexpr int NH = 4, HD = 128, IH = 8, ID = 64, TOPK = 256;
constexpr float EPS = 1e-6f;
constexpr float ATT_SCALE = 0.08838834764831845f;
constexpr float IDX_COEF = 0.125f * 0.35355339059327373f;

constexpr size_t MiB = 1u << 20;
constexpr size_t WS_CTL = 0, CTL_ZERO_BYTES = 64 * 1024;
constexpr size_t WS_WIN = 1 * MiB;
constexpr size_t WS_WO = 8 * MiB;
constexpr size_t WS_WGU = 10 * MiB;
constexpr size_t WS_WD = 21 * MiB;
constexpr size_t WS_WS = 27 * MiB;
constexpr size_t WS_BTAB = 27 * MiB + 256 * 1024;
constexpr size_t WS_RSTD1 = 28 * MiB;
constexpr size_t WS_RSTD3 = 28 * MiB + 256 * 1024;
constexpr size_t WS_SSP = 29 * MiB;
constexpr size_t WS_IW = 31 * MiB;
constexpr size_t WS_XB = 32 * MiB;
constexpr size_t WS_AU = 96 * MiB, WS_AV = 128 * MiB;
constexpr size_t WS_Q = 160 * MiB, WS_K = 192 * MiB, WS_V = 224 * MiB;
constexpr size_t WS_IQ = 256 * MiB;
constexpr size_t WS_IK = 288 * MiB;
constexpr size_t WS_MASK = 292 * MiB;
constexpr size_t WS_MIXIN = 308 * MiB;
constexpr size_t WS_MIXRAW = 372 * MiB;
constexpr size_t WS_X1B = 436 * MiB;
constexpr size_t WS_HMID = 32 * MiB;
constexpr size_t WS_FRAW = 308 * MiB;
constexpr size_t WS_END = 500 * MiB;

constexpr int RING_BYTES = 131072;
constexpr int AUX_OFF = RING_BYTES, AUX_BYTES = 16384;
constexpr int LDSCTL_OFF = AUX_OFF + AUX_BYTES, MISC_OFF = LDSCTL_OFF + 64;
constexpr int LDS_BYTES = 151552;
static_assert(MISC_OFF + 128 <= LDS_BYTES, "LDS map");

__device__ __forceinline__ unsigned cvt_pk_bf16(float lo, float hi) { unsigned r; asm volatile("v_cvt_pk_bf16_f32 %0, %1, %2" : "=v"(r) : "v"(lo), "v"(hi)); return r; }
__device__ __forceinline__ float bf_lo(unsigned w) { return __uint_as_float(w << 16); }
__device__ __forceinline__ float bf_hi(unsigned w) { return __uint_as_float(w & 0xffff0000u); }
__device__ __forceinline__ float wave_sum(float v) {
#pragma unroll
    for (int o = 1; o < 64; o <<= 1) v += __shfl_xor(v, o);
    return v;
}
namespace pg8 {
#define PG8_LAS __attribute__((address_space(3)))
typedef unsigned short bf16_t;
typedef short bf16x8 __attribute__((ext_vector_type(8)));
typedef float f32x4 __attribute__((ext_vector_type(4)));
typedef unsigned u32x4 __attribute__((ext_vector_type(4)));
constexpr int BM = 256, BK = 64, HALF = 128, HTB = HALF * BK * 2  , STAGE_BYTES = 8 * HTB, NXCD = 8, WGM = 8;

__host__ __device__ __forceinline__ int lds_byte(int r, int c) { const int st = (r >> 4) * 2 + (c >> 5), rr = r & 15, cc = c & 31, ob = rr * 64 + cc * 2; return st * 1024 + (ob ^ (((ob >> 9) & 1) << 5)); }
__host__ __device__ __forceinline__ void stage_rc(int b, int& R, int& C) { const int st = b / 1024, sb = b % 1024, swz = sb ^ (((sb >> 9) & 1) << 5); R = (st >> 1) * 16 + swz / 64; C = (st & 1) * 32 + (swz % 64) / 2; }
__host__ __device__ __forceinline__ int perm32(int rho) { const int n = rho >> 4, i = rho & 15; return 8 * (i >> 2) + 4 * n + (i & 3); }

struct Unit { int pm, pn; };
struct Gemm { const bf16_t* A; const bf16_t* Bt; int M, N, K; };

struct StaticOrder {
    int nM, nN, nwg, G, c;
    __host__ __device__ void init(int M, int N, int G_, int c_) { nM = M / BM; nN = N / BM; nwg = nM * nN; G = G_; c = c_; }
    __host__ __device__ bool next(int i, Unit& u) const {
        const long L = (long)i * G + c; if (L >= nwg) return false;
        int wgid = (int)L; { const int q = nwg / NXCD, r = nwg % NXCD, xcd = wgid % NXCD, off = wgid / NXCD; wgid = (xcd < r ? xcd * (q + 1) : r * (q + 1) + (xcd - r) * q) + off; }
        const int nig = WGM * nN, gid = wgid / nig, fm = gid * WGM, gsz = (nM - fm) < WGM ? (nM - fm) : WGM;
        u.pm = fm + ((wgid % nig) % gsz); u.pn = (wgid % nig) / gsz; return true;
    }
    __device__ __forceinline__ void a_ready(const Unit&) const {}
    __device__ __forceinline__ void done(const Unit&) const {}
};

}
namespace pg8 {
struct EpiProj {
    static constexpr bool PERM = true, AFTER_DRAIN = false;
    const float* rstd; bf16_t *AU, *AV, *Q, *K, *V, *IQ, *IK; float* IW;
    __device__ __forceinline__ void operator()(const f32x4 (&acc)[2][2][4][2], const Unit& u, int wr, int wc, int fr, int fq) const {
        const int row0 = u.pm * BM + wr * 64 + fr, bidx = u.pm >> 4;
        float sc[2][4];
#pragma unroll
        for (int ai = 0; ai < 2; ++ai)
#pragma unroll
            for (int m = 0; m < 4; ++m) sc[ai][m] = rstd[row0 + ai * HALF + m * 16];
#pragma unroll
        for (int bj = 0; bj < 2; ++bj) {
            const int c0 = u.pn * BM + bj * HALF + wc * 32 + 8 * fq, reg = c0 >> 9, w = c0 & 511;
            bf16_t* base = nullptr; int stride = 0; int kind = 0;
            if (reg == 0) { base = AU + w; stride = 512; }
            else if (reg == 1) { base = AV + w; stride = 512; }
            else if (reg <= 4) { bf16_t* t = reg == 2 ? Q : (reg == 3 ? K : V); base = t + ((size_t)bidx * 3 * SEQ + (size_t)(w >> 7) * SEQ) * 128 + (w & 127); stride = 128; }
            else if (reg == 5) { base = IQ + w; stride = 512; }
            else if (w < 64) { base = IK + w; stride = 64; }
            else if (w == 64) { kind = 1; }
            else kind = 2;
#pragma unroll
            for (int ai = 0; ai < 2; ++ai)
#pragma unroll
                for (int m = 0; m < 4; ++m) {
                    const int row = row0 + ai * HALF + m * 16; const float s = sc[ai][m];
                    const f32x4 v0 = acc[ai][bj][m][0] * s, v1 = acc[ai][bj][m][1] * s;
                    if (kind == 0) { u32x4 o; o.x = cvt_pk_bf16(v0[0], v0[1]); o.y = cvt_pk_bf16(v0[2], v0[3]); o.z = cvt_pk_bf16(v1[0], v1[1]); o.w = cvt_pk_bf16(v1[2], v1[3]);
                        *(u32x4*)(base + (size_t)row * stride) = o; }
                    else if (kind == 1) { *(f32x4*)(IW + (size_t)row * 8) = v0; *(f32x4*)(IW + (size_t)row * 8 + 4) = v1; }
                }
        }
    }
};
struct EpiRaw {
    static constexpr bool PERM = true, AFTER_DRAIN = false;
    bf16_t* O; float* ssp;
    __device__ __forceinline__ void operator()(const f32x4 (&acc)[2][2][4][2], const Unit& u, int wr, int wc, int fr, int fq) const {
        const int row0 = u.pm * BM + wr * 64 + fr, col0 = u.pn * BM + wc * 32 + 8 * fq;
#pragma unroll
        for (int ai = 0; ai < 2; ++ai)
#pragma unroll
            for (int m = 0; m < 4; ++m) {
                const int row = row0 + ai * HALF + m * 16; float q = 0.f;
#pragma unroll
                for (int bj = 0; bj < 2; ++bj) { const f32x4 v0 = acc[ai][bj][m][0], v1 = acc[ai][bj][m][1];
                    q += (v0[0] * v0[0] + v0[1] * v0[1]) + (v0[2] * v0[2] + v0[3] * v0[3]) + (v1[0] * v1[0] + v1[1] * v1[1]) + (v1[2] * v1[2] + v1[3] * v1[3]);
                    u32x4 o; o.x = cvt_pk_bf16(v0[0], v0[1]); o.y = cvt_pk_bf16(v0[2], v0[3]); o.z = cvt_pk_bf16(v1[0], v1[1]); o.w = cvt_pk_bf16(v1[2], v1[3]);
                    *(u32x4*)(O + (size_t)row * 1024 + col0 + bj * HALF) = o; }
                q += __shfl_xor(q, 16); q += __shfl_xor(q, 32);
                if (fq == 0) ssp[(size_t)row * 16 + u.pn * 4 + wc] = q;
            }
    }
};
struct EpiSwiGLU {
    static constexpr bool PERM = true, AFTER_DRAIN = false;
    bf16_t* H; const float* rstd;
    __device__ __forceinline__ void operator()(const f32x4 (&acc)[2][2][4][2], const Unit& u, int wr, int wc, int fr, int fq) const {
        const int row0 = u.pm * BM + wr * 64 + fr, col0 = u.pn * HALF + wc * 32 + 8 * fq;
#pragma unroll
        for (int ai = 0; ai < 2; ++ai)
#pragma unroll
            for (int m = 0; m < 4; ++m) {
                const int row = row0 + ai * HALF + m * 16; const float s = rstd[row];
                float hv[8];
#pragma unroll
                for (int n = 0; n < 2; ++n)
#pragma unroll
                    for (int e = 0; e < 4; ++e) { const float g = acc[ai][0][m][n][e] * s, up = acc[ai][1][m][n][e] * s;
                        hv[n * 4 + e] = g * __builtin_amdgcn_rcpf(1.f + __builtin_amdgcn_exp2f(-1.4426950408889634f * g)) * up; }
                u32x4 o; o.x = cvt_pk_bf16(hv[0], hv[1]); o.y = cvt_pk_bf16(hv[2], hv[3]); o.z = cvt_pk_bf16(hv[4], hv[5]); o.w = cvt_pk_bf16(hv[6], hv[7]);
                *(u32x4*)(H + (size_t)row * DFF + col0) = o;
            }
    }
};
}
namespace pg8 {
template <class Epi, class Sched, bool ALIGN_EPI = false, bool SP2 = false>
__device__ __forceinline__ void gemm_phase(PG8_LAS unsigned char* lds, const Gemm g, const Sched& S, const Epi& E) {
    const int tid = threadIdx.x, wid = __builtin_amdgcn_readfirstlane(tid >> 6), lane = tid & 63, wr = wid >> 2, wc = wid & 3, fr = lane & 15, fq = lane >> 4;
    const int K = g.K, nt = K / BK;
    unsigned voffA[2], voffB[2];
#pragma unroll
    for (int i = 0; i < 2; ++i) { int R, C; stage_rc(tid * 16 + i * 8192, R, C); const int Rb = Epi::PERM ? ((R & ~31) + perm32(R & 31)) : R;
        voffA[i] = (unsigned)(R * K + C) * 2u; voffB[i] = (unsigned)(Rb * K + C) * 2u; }
    const size_t kstep = (size_t)(BK * 2);
    const size_t hstep = (size_t)HALF * K * 2;
    const size_t tstep = 2 * hstep;
    const unsigned ldsw = (unsigned)wid * 1024u;
    const int aoff = lds_byte(wr * 64 + fr, fq * 8), boff = lds_byte(wc * 32 + fr, fq * 8);
#define PG8_SA(b, h) (((b) * 2 + (h)) * HTB)
#define PG8_SB(b, h) ((4 + (b) * 2 + (h)) * HTB)
#define PG8_STAGE(bufoff, gbase, voff) do { _Pragma("unroll") for (int _i = 0; _i < 2; ++_i) \
        __builtin_amdgcn_global_load_lds((const unsigned*)((const char*)(gbase) + (voff)[_i]), (PG8_LAS unsigned*)(lds + (bufoff) + ldsw + _i * 8192), 16, 0, 0); } while (0)
#define PG8_LDA(dst, b, h) do { _Pragma("unroll") for (int m = 0; m < 4; ++m) _Pragma("unroll") for (int k = 0; k < 2; ++k) dst[m][k] = *(const PG8_LAS bf16x8*)(lds + PG8_SA(b, h) + aoff + m * 2048 + k * 1024); } while (0)
#define PG8_LDB(dst, b, h) do { _Pragma("unroll") for (int n = 0; n < 2; ++n) _Pragma("unroll") for (int k = 0; k < 2; ++k) dst[n][k] = *(const PG8_LAS bf16x8*)(lds + PG8_SB(b, h) + boff + n * 2048 + k * 1024); } while (0)
#define PG8_MMA(ai, bj, At, Bt) do { __builtin_amdgcn_s_setprio(1); _Pragma("unroll") for (int m = 0; m < 4; ++m) _Pragma("unroll") for (int n = 0; n < 2; ++n) _Pragma("unroll") for (int k = 0; k < 2; ++k) \
        acc[ai][bj][m][n] = __builtin_amdgcn_mfma_f32_16x16x32_bf16(Bt[n][k], At[m][k], acc[ai][bj][m][n], 0, 0, 0); __builtin_amdgcn_s_setprio(0); } while (0)
#define PG8_WAIT_V(n) asm volatile("s_waitcnt vmcnt(" #n ")" ::: "memory")
#define PG8_WAIT_L(n) asm volatile("s_waitcnt lgkmcnt(" #n ")" ::: "memory")
#define PG8_BAR __builtin_amdgcn_s_barrier()
#define PG8_SCHED __builtin_amdgcn_sched_barrier(0)
    Unit cur, nxt; int ui = 0;
    if (!S.next(0, cur)) return;
    f32x4 acc[2][2][4][2];
#pragma unroll
    for (int a = 0; a < 2; ++a)
#pragma unroll
        for (int b = 0; b < 2; ++b)
#pragma unroll
            for (int m = 0; m < 4; ++m)
#pragma unroll
                for (int n = 0; n < 2; ++n) acc[a][b][m][n] = (f32x4){0.f, 0.f, 0.f, 0.f};
    bf16x8 At[4][2], B0[2][2], B1[2][2];
    const char* cA = (const char*)g.A + (size_t)cur.pm * tstep; const char* cB = (const char*)g.Bt + (size_t)cur.pn * tstep;
    S.a_ready(cur);
    if constexpr (SP2) {
        PG8_STAGE(PG8_SB(0, 0), cB, voffB); PG8_STAGE(PG8_SB(0, 1), cB + hstep, voffB); PG8_STAGE(PG8_SA(0, 0), cA, voffA); PG8_STAGE(PG8_SA(0, 1), cA + hstep, voffA);
        if (wr == 1) PG8_BAR;
        PG8_WAIT_V(2); PG8_BAR;
        PG8_STAGE(PG8_SB(1, 0), cB + kstep, voffB); PG8_STAGE(PG8_SA(1, 0), cA + kstep, voffA); PG8_STAGE(PG8_SB(1, 1), cB + hstep + kstep, voffB);
        PG8_WAIT_V(6); PG8_BAR;
    } else {
        PG8_STAGE(PG8_SB(0, 0), cB, voffB); PG8_STAGE(PG8_SA(0, 0), cA, voffA); PG8_STAGE(PG8_SB(0, 1), cB + hstep, voffB); PG8_STAGE(PG8_SA(0, 1), cA + hstep, voffA);
        if (wr == 1) PG8_BAR;
        PG8_WAIT_V(4); PG8_BAR;
        PG8_STAGE(PG8_SB(1, 0), cB + kstep, voffB); PG8_STAGE(PG8_SA(1, 0), cA + kstep, voffA); PG8_STAGE(PG8_SB(1, 1), cB + hstep + kstep, voffB);
        PG8_WAIT_V(6); PG8_BAR;
    }
    for (;;) {
        const bool has_next = S.next(ui + 1, nxt);
        const char* nA = has_next ? (const char*)g.A + (size_t)nxt.pm * tstep : cA; const char* nB = has_next ? (const char*)g.Bt + (size_t)nxt.pn * tstep : cB;
        for (int t = 0; t < nt; t += 2) {
            const bool last = (t == nt - 2);
            const char* a1 = cA + (size_t)(t + 1) * kstep;
            const char* a2 = last ? nA : cA + (size_t)(t + 2) * kstep; const char* b2 = last ? nB : cB + (size_t)(t + 2) * kstep;
            const char* a3 = a2 + kstep; const char* b3 = b2 + kstep;
            if (last && has_next) S.a_ready(nxt);
            if constexpr (SP2) {
            PG8_LDB(B0, 0, 0); PG8_LDB(B1, 0, 1); PG8_SCHED; PG8_LDA(At, 0, 0); PG8_STAGE(PG8_SA(1, 1), a1 + hstep, voffA);
            PG8_WAIT_V(8); PG8_WAIT_L(0); PG8_BAR; PG8_MMA(0, 0, At, B0); PG8_MMA(0, 1, At, B1); PG8_BAR; PG8_SCHED;
            PG8_LDA(At, 0, 1); PG8_STAGE(PG8_SB(0, 0), b2, voffB); PG8_STAGE(PG8_SB(0, 1), b2 + hstep, voffB); PG8_STAGE(PG8_SA(0, 0), a2, voffA);
            PG8_WAIT_V(8); PG8_WAIT_L(0); PG8_BAR; PG8_MMA(1, 0, At, B0); PG8_MMA(1, 1, At, B1); PG8_BAR; PG8_SCHED;
            PG8_LDB(B0, 1, 0); PG8_LDB(B1, 1, 1); PG8_SCHED; PG8_LDA(At, 1, 0); PG8_STAGE(PG8_SA(0, 1), a2 + hstep, voffA);
            PG8_WAIT_V(8); PG8_WAIT_L(0); PG8_BAR; PG8_MMA(0, 0, At, B0); PG8_MMA(0, 1, At, B1); PG8_BAR; PG8_SCHED;
            PG8_LDA(At, 1, 1); PG8_STAGE(PG8_SB(1, 0), b3, voffB); PG8_STAGE(PG8_SB(1, 1), b3 + hstep, voffB); PG8_STAGE(PG8_SA(1, 0), a3, voffA);
            PG8_WAIT_V(8); PG8_WAIT_L(0); PG8_BAR; PG8_MMA(1, 0, At, B0); PG8_MMA(1, 1, At, B1); PG8_BAR; PG8_SCHED;
            } else {
            PG8_LDB(B0, 0, 0); PG8_SCHED; PG8_LDA(At, 0, 0); PG8_STAGE(PG8_SA(1, 1), a1 + hstep, voffA);
            PG8_WAIT_L(8); PG8_BAR; PG8_WAIT_L(0); PG8_MMA(0, 0, At, B0); PG8_BAR; PG8_SCHED;
            PG8_LDB(B1, 0, 1); PG8_STAGE(PG8_SB(0, 0), b2, voffB);
            PG8_BAR; PG8_WAIT_L(0); PG8_MMA(0, 1, At, B1); PG8_BAR;
            PG8_LDA(At, 0, 1); PG8_STAGE(PG8_SA(0, 0), a2, voffA);
            PG8_BAR; PG8_WAIT_L(0); PG8_MMA(1, 0, At, B0); PG8_BAR; PG8_SCHED;
            PG8_STAGE(PG8_SB(0, 1), b2 + hstep, voffB);
            PG8_WAIT_V(6); PG8_BAR; PG8_MMA(1, 1, At, B1); PG8_BAR;
            PG8_LDB(B0, 1, 0); PG8_SCHED; PG8_LDA(At, 1, 0); PG8_STAGE(PG8_SA(0, 1), a2 + hstep, voffA);
            PG8_WAIT_L(8); PG8_BAR; PG8_WAIT_L(0); PG8_MMA(0, 0, At, B0); PG8_BAR; PG8_SCHED;
            PG8_LDB(B1, 1, 1); PG8_STAGE(PG8_SB(1, 0), b3, voffB);
            PG8_BAR; PG8_WAIT_L(0); PG8_MMA(0, 1, At, B1); PG8_BAR;
            PG8_LDA(At, 1, 1); PG8_STAGE(PG8_SA(1, 0), a3, voffA);
            PG8_BAR; PG8_WAIT_L(0); PG8_MMA(1, 0, At, B0); PG8_BAR; PG8_SCHED;
            PG8_STAGE(PG8_SB(1, 1), b3 + hstep, voffB);
            PG8_WAIT_V(6); PG8_BAR; PG8_MMA(1, 1, At, B1); PG8_BAR;
            }
        }
        if constexpr (ALIGN_EPI) { if (wr == 0) PG8_BAR; }
        if constexpr (!Epi::AFTER_DRAIN) { E(acc, cur, wr, wc, fr, fq); S.done(cur); }
        if (!has_next) break;
#pragma unroll
        for (int a = 0; a < 2; ++a)
#pragma unroll
            for (int b = 0; b < 2; ++b)
#pragma unroll
                for (int m = 0; m < 4; ++m)
#pragma unroll
                    for (int n = 0; n < 2; ++n) acc[a][b][m][n] = (f32x4){0.f, 0.f, 0.f, 0.f};
        cur = nxt; cA = nA; cB = nB; ++ui;
        if constexpr (ALIGN_EPI) { if (wr == 1) PG8_BAR; }
    }
    PG8_WAIT_V(0);
    if constexpr (!ALIGN_EPI) { if (wr == 0) PG8_BAR; }
    PG8_BAR;
    if constexpr (Epi::AFTER_DRAIN) { E.fused(acc, cur, wr, wc, fr, fq, lds, wid, lane); S.done(cur); }
#undef PG8_SA
#undef PG8_SB
#undef PG8_STAGE
#undef PG8_LDA
#undef PG8_LDB
#undef PG8_MMA
#undef PG8_WAIT_V
#undef PG8_WAIT_L
#undef PG8_BAR
#undef PG8_SCHED
}
}
#include <hip/hip_bf16.h>
namespace att {
using TIN = __hip_bfloat16; using TOUT = __hip_bfloat16;
constexpr int B = NB, H = NH, HKV = NH, SQ = SEQ, SKV = SEQ, D = 128, QOFF = 0, WINDOW = SEQ;
constexpr float THR = 8.f;
constexpr bool WSKIP = false;
constexpr int OPITCH = DM;
__device__ __forceinline__ void sel_tile(f32x16& p0, f32x16& p1, unsigned long long mw, bool beyond, bool bias,
                                         const float* __restrict__ bt, int bi) {
    const float NEG = -__builtin_inff();
    if (beyond) {
#pragma unroll
        for (int r = 0; r < 16; ++r) { p0[r] = NEG; p1[r] = NEG; }
        return;
    }
    if (bias) {
#pragma unroll
        for (int r = 0; r < 16; ++r) { const int c = (r & 3) + 8 * (r >> 2); p0[r] += bt[bi + c]; p1[r] += bt[bi + c + 32]; }
    }
    const unsigned lo = (unsigned)mw, hi = (unsigned)(mw >> 32);
#pragma unroll
    for (int r = 0; r < 16; ++r) {
        const unsigned long long m0 = ((unsigned long long)(unsigned)__builtin_amdgcn_readlane((int)hi, r) << 32) | (unsigned)__builtin_amdgcn_readlane((int)lo, r);
        const unsigned long long m1 = ((unsigned long long)(unsigned)__builtin_amdgcn_readlane((int)hi, 16 + r) << 32) | (unsigned)__builtin_amdgcn_readlane((int)lo, 16 + r);
        p0[r] = __builtin_amdgcn_inverse_ballot_w64(m0) ? p0[r] : NEG;
        p1[r] = __builtin_amdgcn_inverse_ballot_w64(m1) ? p1[r] : NEG;
    }
}
constexpr float SCALE = 0.08838834764831845f;
constexpr int NW = 8, QBLK = 32, KVBLK = 64, QB = NW * QBLK;
constexpr int SHM_V = KVBLK * D * 2, SHM_K = KVBLK * D * 2;
constexpr int LDS_BYTES = 2 * SHM_V + 2 * SHM_K + NW * 64 * 4;
static_assert(D == 128 && SQ % QB == 0 && SKV % KVBLK == 0 && H % HKV == 0 && QOFF >= 0 && QOFF + SQ <= SKV && WINDOW >= 1, "geometry");

using bf16 = __hip_bfloat16;
typedef short bf16x8 __attribute__((ext_vector_type(8)));
typedef short s16x4 __attribute__((ext_vector_type(4)));
typedef float f32x16 __attribute__((ext_vector_type(16)));
typedef float f32x4 __attribute__((ext_vector_type(4)));
typedef unsigned u32x4 __attribute__((ext_vector_type(4)));
template <class A, class Bt> struct same_t { static constexpr bool v = false; };
template <class A> struct same_t<A, A> { static constexpr bool v = true; };

#define KSWZ(row, colB) ((row) * 256 + ((colB) ^ (((row) & 7) << 4)))
#define SBAR() __builtin_amdgcn_sched_barrier(0)
__device__ __forceinline__ int v_st(int k, int c) { const int kk = (k & ~0xC) | ((k & 4) << 1) | ((k & 8) >> 1); return ((kk >> 3) * 4 + (c >> 5)) * 512 + ((kk & 7) * 32 + (c & 31)) * 2; }
__device__ __forceinline__ int v_rd_base(int lane) { return ((lane & 3) << 3) | (((lane >> 2) & 3) << 6) | (((lane >> 4) & 1) << 5) | (((lane >> 5) & 1) << 8); }
constexpr int v_rd_off(int d0, int ks, int half) { return d0 * 512 + ks * 4096 + half * 2048; }
__device__ __forceinline__ int crow(int r, int hi) { return (r & 3) + 8 * (r >> 2) + 4 * hi; }
__device__ __forceinline__ unsigned cvtpk(float lo, float hi) {
    unsigned r; asm volatile("v_cvt_pk_bf16_f32 %0, %1, %2" : "=v"(r) : "v"(lo), "v"(hi)); return r;
}
__device__ __forceinline__ bf16x8 pack8(f32x4 a, f32x4 b) {
    u32x4 w = {cvtpk(a[0], a[1]), cvtpk(a[2], a[3]), cvtpk(b[0], b[1]), cvtpk(b[2], b[3])};
    return *reinterpret_cast<bf16x8*>(&w);
}
template <class T> __device__ __forceinline__ bf16x8 load8(const T* p) {
    if constexpr (same_t<T, float>::v) { return pack8(*(const f32x4*)p, *(const f32x4*)(p + 4)); }
    else { return *reinterpret_cast<const bf16x8*>(p); }
}
__device__ __forceinline__ void mask_tile(f32x16& p0, f32x16& p1, int dq, unsigned W) {
    const float NEG = -__builtin_inff();
#pragma unroll
    for (int r = 0; r < 16; ++r) {
        const int c = (r & 3) + 8 * (r >> 2);
        if ((unsigned)(dq - c) >= W) p0[r] = NEG;
        if ((unsigned)(dq - c - 32) >= W) p1[r] = NEG;
    }
}
__device__ __forceinline__ void partialSM(f32x16& p0, f32x16& p1, float& m_reg, float& mn, float& alpha) {
    float pmax = p0[0]; for (int r = 1; r < 16; ++r) pmax = fmaxf(pmax, p0[r]); for (int r = 0; r < 16; ++r) pmax = fmaxf(pmax, p1[r]);
    { auto rr = __builtin_amdgcn_permlane32_swap(__float_as_uint(pmax), __float_as_uint(pmax), false, false);
      pmax = fmaxf(__uint_as_float(rr[0]), __uint_as_float(rr[1])); }
    constexpr float C2 = 1.4426950408889634f * SCALE;
    if (__builtin_expect(__all((pmax - m_reg) * SCALE <= THR), 1)) { mn = m_reg; alpha = 1.f; }
    else { mn = fmaxf(m_reg, pmax); alpha = __builtin_amdgcn_exp2f((m_reg - mn) * C2); m_reg = mn; }
    const float mnL = -mn * C2;
    for (int r = 0; r < 16; ++r) p0[r] = fmaf(p0[r], C2, mnL); for (int r = 0; r < 16; ++r) p1[r] = fmaf(p1[r], C2, mnL);
    for (int r = 0; r < 16; ++r) p0[r] = __builtin_amdgcn_exp2f(p0[r]);
}
__device__ __forceinline__ void finishSM(f32x16& p0, f32x16& p1, float alpha, float& l_reg, bf16x8& pa0, bf16x8& pa1, bf16x8& pa2, bf16x8& pa3) {
    for (int r = 0; r < 16; ++r) p1[r] = __builtin_amdgcn_exp2f(p1[r]);
    float ps = 0; for (int r = 0; r < 16; ++r) ps += p0[r]; for (int r = 0; r < 16; ++r) ps += p1[r];
    { auto rr = __builtin_amdgcn_permlane32_swap(__float_as_uint(ps), __float_as_uint(ps), false, false);
      ps = __uint_as_float(rr[0]) + __uint_as_float(rr[1]); }
    l_reg = l_reg * alpha + ps;
#define PK4(P, B_, OUT) do { unsigned a0 = cvtpk(P[B_+0], P[B_+1]), a1 = cvtpk(P[B_+2], P[B_+3]);                          \
        unsigned b0 = cvtpk(P[B_+4], P[B_+5]), b1 = cvtpk(P[B_+6], P[B_+7]);                                             \
        auto r0 = __builtin_amdgcn_permlane32_swap(a0, b0, false, false); auto r1 = __builtin_amdgcn_permlane32_swap(a1, b1, false, false); \
        u32x4 w = {r0[0], r1[0], r0[1], r1[1]}; OUT = *reinterpret_cast<bf16x8*>(&w); } while (0)
    PK4(p0, 0, pa0); PK4(p0, 8, pa1); PK4(p1, 0, pa2); PK4(p1, 8, pa3);
#undef PK4
}
template <int KB, bool SK>
__device__ __forceinline__ void qkt(f32x16& p0, f32x16& p1, const char* K_lds, int r32, int hi, const bf16x8* qr, bool act) {
    if (SK && !act) { const float NEG = -__builtin_inff();
#pragma unroll
        for (int r = 0; r < 16; ++r) { p0[r] = NEG; p1[r] = NEG; } return; }
    p0 = f32x16{}; p1 = f32x16{};
    const char* kb[4];
#pragma unroll
    for (int dd = 0; dd < 4; ++dd) kb[dd] = K_lds + KB * SHM_K + KSWZ(r32, (dd * 16 + hi * 8) * 2);
#pragma unroll
    for (int d0 = 0; d0 < 8; ++d0) { const char* a = kb[d0 & 3] + (d0 >> 2) * 128;
        bf16x8 b0 = *reinterpret_cast<const bf16x8*>(a);
        bf16x8 b1 = *reinterpret_cast<const bf16x8*>(a + 32 * 256);
        p0 = __builtin_amdgcn_mfma_f32_32x32x16_bf16(b0, qr[d0], p0, 0, 0, 0);
        p1 = __builtin_amdgcn_mfma_f32_32x32x16_bf16(b1, qr[d0], p1, 0, 0, 0); }
}
template <int VB, bool SK>
__device__ __forceinline__ void pv_tile(f32x16* o, int vb0, bf16x8 pa0, bf16x8 pa1, bf16x8 pa2, bf16x8 pa3, bool act) {
    if (SK && !act) return;
#define TRRD(dst, off) asm volatile("ds_read_b64_tr_b16 %0, %1 offset:%2" : "=&v"(dst) : "v"(vb0), "i"(off) : "memory")
#define PV_D0(d0) do { s16x4 l0, l1, l2, l3, h0, h1, h2, h3; constexpr int b_ = VB * SHM_V + v_rd_off(d0, 0, 0);     \
        TRRD(l0, b_); TRRD(h0, b_ + 2048); TRRD(l1, b_ + 4096); TRRD(h1, b_ + 6144); TRRD(l2, b_ + 8192); TRRD(h2, b_ + 10240); TRRD(l3, b_ + 12288); TRRD(h3, b_ + 14336); \
        asm volatile("s_waitcnt lgkmcnt(0)" ::: "memory"); SBAR();                 \
        o[d0] = __builtin_amdgcn_mfma_f32_32x32x16_bf16(pa0, (bf16x8){l0[0], l0[1], l0[2], l0[3], h0[0], h0[1], h0[2], h0[3]}, o[d0], 0, 0, 0);   \
        o[d0] = __builtin_amdgcn_mfma_f32_32x32x16_bf16(pa1, (bf16x8){l1[0], l1[1], l1[2], l1[3], h1[0], h1[1], h1[2], h1[3]}, o[d0], 0, 0, 0);   \
        o[d0] = __builtin_amdgcn_mfma_f32_32x32x16_bf16(pa2, (bf16x8){l2[0], l2[1], l2[2], l2[3], h2[0], h2[1], h2[2], h2[3]}, o[d0], 0, 0, 0);   \
        o[d0] = __builtin_amdgcn_mfma_f32_32x32x16_bf16(pa3, (bf16x8){l3[0], l3[1], l3[2], l3[3], h3[0], h3[1], h3[2], h3[3]}, o[d0], 0, 0, 0); } while (0)
    PV_D0(0); PV_D0(1); PV_D0(2); PV_D0(3);
#undef PV_D0
#undef TRRD
}

template <class TIn, class TOut> struct BlockRef { const TIn* Q; const TIn* K; const TIn* V; TOut* O; int P0; const unsigned long long* M; const float* BT; };
template <class TIn> struct Seam {
    bf16x8 qr[8];
    bf16x8 st_v0, st_v1, st_k0, st_k1; f32x4 sf0, sf1, sf2, sf3;
    f32x4 tq[16];
};
__device__ __forceinline__ int swa_jlo(int P0, int W) { const int lowk = P0 - W + 1; return lowk > 0 ? lowk / KVBLK : 0; }
#define ROW(p, k0, rr) ((p) + (size_t)((k0) + (rr)) * D + sc)
#define VMW() asm volatile("s_waitcnt vmcnt(0)" ::: "memory")
#define VMWN(n) asm volatile("s_waitcnt vmcnt(%0)" :: "i"(n) : "memory")
#define SLOAD_H(Kp, Vp, k0) do { S.st_v0 = load8<TIn>(ROW(Vp, k0, sr)); S.st_v1 = load8<TIn>(ROW(Vp, k0, 32 + sr));              \
                         S.st_k0 = load8<TIn>(ROW(Kp, k0, sr)); S.st_k1 = load8<TIn>(ROW(Kp, k0, 32 + sr)); } while (0)
#define SWRITE_HK(bf) do { *(bf16x8*)(K_lds + (bf) * SHM_K + kws) = S.st_k0; *(bf16x8*)(K_lds + (bf) * SHM_K + kws + 32 * 256) = S.st_k1; } while (0)
#define SWRITE_HV(bf) do { *(bf16x8*)(V_lds + (bf) * SHM_V + vst0) = S.st_v0; *(bf16x8*)(V_lds + (bf) * SHM_V + vst1) = S.st_v1; } while (0)
#define SWRITE_H(bf) do { SWRITE_HV(bf); SWRITE_HK(bf); } while (0)
#define SLOAD_F(p, k0) do { S.sf0 = *(const f32x4*)ROW(p, k0, sr); S.sf1 = *(const f32x4*)(ROW(p, k0, sr) + 4);                \
                            S.sf2 = *(const f32x4*)ROW(p, k0, 32 + sr); S.sf3 = *(const f32x4*)(ROW(p, k0, 32 + sr) + 4); } while (0)
#define SWRITE_KF(bf) do { *(bf16x8*)(K_lds + (bf) * SHM_K + kws) = pack8(S.sf0, S.sf1); *(bf16x8*)(K_lds + (bf) * SHM_K + kws + 32 * 256) = pack8(S.sf2, S.sf3); } while (0)
#define SWRITE_VF(bf) do { *(bf16x8*)(V_lds + (bf) * SHM_V + vst0) = pack8(S.sf0, S.sf1); *(bf16x8*)(V_lds + (bf) * SHM_V + vst1) = pack8(S.sf2, S.sf3); } while (0)
template <class TIn, class TOut>
__device__ __forceinline__ void causal_swa_prime(const BlockRef<TIn, TOut>& cur, int W, char* lds, Seam<TIn>& S) {
    constexpr bool F32 = same_t<TIn, float>::v;
    const int tid = threadIdx.x, wid = __builtin_amdgcn_readfirstlane(tid >> 6), lane = tid & 63, r32 = lane & 31, hi = lane >> 5;
    const int sr = tid >> 4, sc = (tid & 15) * 8, kws = KSWZ(sr, sc * 2); char* K_lds = lds + 2 * SHM_V;
    const int kb0 = swa_jlo(cur.P0, W) * KVBLK;
    for (int d0 = 0; d0 < 8; ++d0) S.qr[d0] = load8<TIn>(cur.Q + (size_t)(wid * QBLK + r32) * D + d0 * 16 + hi * 8);
    if constexpr (F32) { SLOAD_F((const float*)cur.K, kb0); VMW(); SWRITE_KF(0); SBAR(); SLOAD_F((const float*)cur.V, kb0); }
    else { SLOAD_H(cur.K, cur.V, kb0); VMW(); SWRITE_HK(0); }
    __syncthreads();
}
template <class TIn, class TOut>
__device__ __forceinline__ void causal_swa_block(const BlockRef<TIn, TOut>& cur, const BlockRef<TIn, TOut>& nxt, int skv, int W, char* lds, Seam<TIn>& S) {
    constexpr bool F32 = same_t<TIn, float>::v;
    const int tid = threadIdx.x, wid = __builtin_amdgcn_readfirstlane(tid >> 6), lane = tid & 63, r32 = lane & 31, hi = lane >> 5;
    const int j_lo = swa_jlo(cur.P0, W);
    int j_hi = (cur.P0 + QB - 1) / KVBLK + 1; if (j_hi > skv / KVBLK) j_hi = skv / KVBLK;
    const int NT = j_hi - j_lo;
    const int kbn = swa_jlo(nxt.P0, W) * KVBLK;
    const int qlo = cur.P0 + wid * QBLK, qm = qlo + r32 - 4 * hi;
    const int cwv = qlo / KVBLK;
    const unsigned long long* Mw = cur.M + (size_t)wid * (64 * 32);
    char* V_lds = lds; char* K_lds = lds + 2 * SHM_V;
    float* ws = (float*)(lds + 2 * SHM_V + 2 * SHM_K) + wid * 64; float* li_l = ws, * al_l = ws + 32;
    float m_reg = -1e30f, l_reg = 0; f32x16 o[4] = {};
    const int sr = tid >> 4, sc = (tid & 15) * 8, vst0 = v_st(sr, sc), vst1 = v_st(32 + sr, sc), kws = KSWZ(sr, sc * 2);
    const int vb0 = (int)(uintptr_t)V_lds + v_rd_base(lane);
    const TIn* Kh = cur.K; const TIn* Vh = cur.V;
#define RESC(a) do { if (__any((a) < 1.f)) { if (hi == 0) al_l[r32] = (a); asm volatile("s_waitcnt lgkmcnt(0)" ::: "memory");              \
                     for (int d_ = 0; d_ < 4; ++d_) for (int r = 0; r < 16; ++r) o[d_][r] *= al_l[crow(r, hi)]; } } while (0)
#define KBASE(t) ((j_lo + (t)) * KVBLK)
#define ACT(t) (KBASE(t) <= qlo + QBLK - 1 && KBASE(t) + KVBLK - 1 >= qlo - W + 1)
#define MLOAD(t) (Mw[(size_t)(t) * 32 + (lane & 31)])
#define MASKT(P0_, P1_, t, mw_) sel_tile(P0_, P1_, (mw_), (t) > cwv, KBASE(t) - qlo >= -128 && (t) <= cwv, cur.BT, KBASE(t) - qlo + 192 - r32 + 4 * hi)
    constexpr int NQL = F32 ? 16 : 8;
    constexpr bool SK = WSKIP && !F32;
#define SEAM_K0() do { VMWN(NQL); if constexpr (F32) { SWRITE_KF(0); SBAR(); SLOAD_F((const float*)nxt.V, kbn); } else { SWRITE_HK(0); } SBAR(); } while (0)
    f32x16 pA0, pA1, pB0, pB1; float mnA, mnB, alA, alB; bf16x8 pa0, pa1, pa2, pa3;
    if constexpr (F32) { VMW(); SWRITE_VF(0); SBAR(); } else { SWRITE_HV(0); SBAR(); }
    if (NT > 1) { if constexpr (F32) SLOAD_F((const float*)Kh, KBASE(1)); else SLOAD_H(Kh, Vh, KBASE(1)); }
    const unsigned long long mw0_ = MLOAD(0); SBAR(); qkt<0, SK>(pA0, pA1, K_lds, r32, hi, S.qr, ACT(0));
    if constexpr (F32) { if (NT > 1) { VMW(); SWRITE_KF(1); SBAR(); SLOAD_F((const float*)Vh, KBASE(1)); } }
    MASKT(pA0, pA1, 0, mw0_); partialSM(pA0, pA1, m_reg, mnA, alA);
    if (NT > 1) { VMW(); if constexpr (F32) { SWRITE_VF(1); SBAR(); if (NT > 2) SLOAD_F((const float*)Kh, KBASE(2)); } else SWRITE_H(1); }
    __syncthreads();
#define HALF_STEP(PX0, PX1, mnX, alX, PY0, PY1, alY, t, KB, VB, SB) do {                                                      \
        const unsigned long long mwt_ = MLOAD(t); SBAR(); qkt<KB, SK>(PX0, PX1, K_lds, r32, hi, S.qr, ACT(t));                                             \
        finishSM(PY0, PY1, alY, l_reg, pa0, pa1, pa2, pa3); SBAR();                                                           \
        if ((t) + 1 < NT) { if constexpr (F32) { VMW(); SWRITE_KF(SB); SBAR(); SLOAD_F((const float*)Vh, KBASE((t) + 1)); }  \
                            else { SLOAD_H(Kh, Vh, KBASE((t) + 1)); } SBAR(); }                                               \
        pv_tile<VB, SK>(o, vb0, pa0, pa1, pa2, pa3, ACT((t) - 1)); MASKT(PX0, PX1, (t), mwt_); partialSM(PX0, PX1, m_reg, mnX, alX);                                        \
        __syncthreads();                                                                                                      \
        if ((t) + 1 < NT) { VMW(); if constexpr (F32) { SWRITE_VF(SB); SBAR(); if ((t) + 2 < NT) SLOAD_F((const float*)Kh, KBASE((t) + 2)); } \
                            else { SWRITE_H(SB); } }                                                                          \
        RESC(alX); __syncthreads(); } while (0)
    for (int t = 1; t + 1 < NT; t += 2) {
        HALF_STEP(pB0, pB1, mnB, alB, pA0, pA1, alA, t, 1, 0, 0);
        HALF_STEP(pA0, pA1, mnA, alA, pB0, pB1, alB, t + 1, 0, 1, 1);
    }
    const bool even = (NT & 1) == 0;
    unsigned long long mwl_ = 0ull; if (even) { mwl_ = MLOAD(NT - 1); SBAR(); qkt<1, SK>(pB0, pB1, K_lds, r32, hi, S.qr, ACT(NT - 1)); SBAR(); }
#define QROW(e) (nxt.Q + (size_t)(wid * QBLK + r32) * D + ((e) >> 1) * 16 + hi * 8 + ((e) & 1) * 4)
    if constexpr (F32) { SLOAD_F((const float*)nxt.K, kbn); SBAR();
#pragma unroll
        for (int e = 0; e < 8; ++e) S.tq[e] = *(const f32x4*)QROW(e); }
    else { SLOAD_H(nxt.K, nxt.V, kbn); SBAR();
#pragma unroll
        for (int d0 = 0; d0 < 8; ++d0) S.qr[d0] = load8<TIn>(nxt.Q + (size_t)(wid * QBLK + r32) * D + d0 * 16 + hi * 8); }
    SBAR();
    finishSM(pA0, pA1, alA, l_reg, pa0, pa1, pa2, pa3); SBAR();
    if constexpr (F32) {
#pragma unroll
        for (int e = 8; e < 16; ++e) S.tq[e] = *(const f32x4*)QROW(e); SBAR(); }
#undef QROW
    pv_tile<0, SK>(o, vb0, pa0, pa1, pa2, pa3, ACT(even ? NT - 2 : NT - 1));
    if (even) { MASKT(pB0, pB1, NT - 1, mwl_); partialSM(pB0, pB1, m_reg, mnB, alB); __syncthreads(); RESC(alB);
        finishSM(pB0, pB1, alB, l_reg, pa0, pa1, pa2, pa3); SBAR(); pv_tile<1, SK>(o, vb0, pa0, pa1, pa2, pa3, ACT(NT - 1)); }
    SBAR(); SEAM_K0();
    if (hi == 0) li_l[r32] = l_reg; asm volatile("s_waitcnt lgkmcnt(0)" ::: "memory");
    float rli[16];
#pragma unroll
    for (int r = 0; r < 16; ++r) rli[r] = __builtin_amdgcn_rcpf(li_l[crow(r, hi)]);
    TOut* Ow = cur.O + (size_t)(wid * QBLK) * OPITCH;
#pragma unroll
    for (int r = 0; r < 16; ++r) { const int orow = crow(r, hi);
#pragma unroll
        for (int d0 = 0; d0 < 4; ++d0) { const float v = o[d0][r] * rli[r];
            if constexpr (same_t<TOut, float>::v) { Ow[(size_t)orow * OPITCH + d0 * 32 + r32] = v; }
            else { const float vn = __shfl_xor(v, 1);
                   if ((r32 & 1) == 0) *(unsigned*)(Ow + (size_t)orow * OPITCH + d0 * 32 + r32) = cvtpk(v, vn); } } }
    if constexpr (F32) {
#pragma unroll
        for (int d0 = 0; d0 < 8; ++d0) S.qr[d0] = pack8(S.tq[2 * d0], S.tq[2 * d0 + 1]); }
    __syncthreads();
#undef RESC
#undef KBASE
#undef ACT
#undef MASKT
#undef MLOAD
#undef SEAM_K0
#undef HALF_STEP
}
#undef ROW
#undef VMW
#undef VMWN
#undef SLOAD_H
#undef SWRITE_HK
#undef SWRITE_HV
#undef SWRITE_H
#undef SLOAD_F
#undef SWRITE_KF
#undef SWRITE_VF

struct AttnArgs { const __hip_bfloat16* Q; const __hip_bfloat16* K; const __hip_bfloat16* V; __hip_bfloat16* O; const unsigned long long* MASK; const float* BTAB; };
__device__ __forceinline__ BlockRef<TIN, TOUT> make_ref(const AttnArgs& A, int item, int pass) {
    const int b = item >> 5, h = (item >> 3) & 3, x = item & 7, qb = pass ? 15 - x : x;
    BlockRef<TIN, TOUT> r;
    r.Q = A.Q + ((size_t)(b * NH + h) * SEQ + (size_t)qb * QB) * D;
    r.K = A.K + (size_t)(b * NH + h) * SEQ * D; r.V = A.V + (size_t)(b * NH + h) * SEQ * D;
    r.O = A.O + ((size_t)b * SEQ + (size_t)qb * QB) * OPITCH + 512 + h * 128;
    r.P0 = qb * QB;
    r.M = A.MASK + ((size_t)(b * 128 + qb * 8) * 64) * 32;
    r.BT = A.BTAB + h * 256;
    return r;
}
__device__ __forceinline__ void attn_phase(char* lds, const AttnArgs& A, int vcu, int G) {
    if (vcu >= 256) return;
    int item = vcu, pass = 0;
    BlockRef<TIN, TOUT> cur = make_ref(A, item, 0);
    Seam<TIN> S;
    causal_swa_prime<TIN, TOUT>(cur, WINDOW, lds, S);
    for (;;) {
        const bool more_pass = pass == 0, more_item = item + G < 256, last = !more_pass && !more_item;
        int itn = item, pn = pass + 1;
        if (!more_pass) { pn = 0; itn = more_item ? item + G : item; }
        const BlockRef<TIN, TOUT> nxt = last ? cur : make_ref(A, itn, pn);
        causal_swa_block<TIN, TOUT>(cur, nxt, SKV, WINDOW, lds, S);
        if (last) break;
        cur = nxt; item = itn; pass = pn;
    }
}
#undef KSWZ
#undef SBAR
}
#define XB_TMO      128
#define XB_XCNT(j)  (256  + 64 * (j))
#define XB_XSUB(j)  (1280 + 64 * (j))
#define XB_XGEN(j)  (2304 + 64 * (j))
#define XB_TOP      3328
#define XB_TOPGEN   3392
#define XCD_BAR_WORDS 3456
#define XB_SPIN_CAP (1u << 18)

__device__ __forceinline__ unsigned xb_ld(unsigned* p)              { return __hip_atomic_load(p, __ATOMIC_RELAXED, __HIP_MEMORY_SCOPE_AGENT); }
__device__ __forceinline__ unsigned xb_add(unsigned* p, unsigned v) { return __hip_atomic_fetch_add(p, v, __ATOMIC_RELAXED, __HIP_MEMORY_SCOPE_AGENT); }
__device__ __forceinline__ unsigned xb_xcc_id() { return (unsigned)__builtin_amdgcn_s_getreg((3 << 11) | 20) & 0xFu; }
#define XB_SPIN(cond, bar) do { unsigned _sp = 0; while (cond) { __builtin_amdgcn_s_sleep(1); \
    if ((++_sp & 255u) == 0u) { if (xb_ld(&(bar)[XB_TMO])) break; if (_sp > XB_SPIN_CAP) { atomicAdd(&(bar)[XB_TMO], 1u); break; } } } } while (0)

struct XcdBarrier {
    unsigned* bar; unsigned x;
    volatile LAS unsigned* st;
};

__device__ __forceinline__ XcdBarrier xcd_barrier_post(unsigned* bar, volatile LAS unsigned* st) {
    XcdBarrier b; b.bar = bar; b.x = xb_xcc_id(); b.st = st;
    if (threadIdx.x == 0) (void)xb_add(&bar[XB_XCNT(b.x)], 1u);
    return b;
}
__device__ __forceinline__ void xcd_barrier_complete(unsigned* bar, unsigned x, unsigned& nloc, unsigned& nx) {
    const unsigned G = gridDim.x * gridDim.y * gridDim.z;
    unsigned sum, cnt, mine, sp = 0u;
    for (;;) {
        sum = 0u; cnt = 0u; mine = 0u;
#pragma unroll
        for (unsigned j = 0; j < 16; ++j) { const unsigned c = xb_ld(&bar[XB_XCNT(j)]); sum += c; cnt += (c > 0u) ? 1u : 0u; mine = (j == x) ? c : mine; }
        if (sum == G) break;
        __builtin_amdgcn_s_sleep(1);
        if ((++sp & 255u) == 0u) { if (xb_ld(&bar[XB_TMO])) break; if (sp > XB_SPIN_CAP) { atomicAdd(&bar[XB_TMO], 1u); break; } }
    }
    nloc = mine > 0u ? mine : 1u; nx = cnt > 0u ? cnt : 1u;
}

__device__ __forceinline__ void xcd_barrier(const XcdBarrier& b) {
    asm volatile("s_waitcnt vmcnt(0)" ::: "memory");
    __syncthreads();
    if (threadIdx.x == 0) {
        unsigned* bar = b.bar;
        __builtin_amdgcn_s_waitcnt(0);
        unsigned nloc = b.st[0], nx = b.st[1];
        if (nloc == 0u) { xcd_barrier_complete(bar, b.x, nloc, nx); b.st[0] = nloc; b.st[1] = nx; }
        const unsigned old = xb_add(&bar[XB_XSUB(b.x)], 1u);
        const unsigned gen = old / nloc;
        if (old + 1u == (gen + 1u) * nloc) {
            __builtin_amdgcn_fence(__ATOMIC_RELEASE, "agent");
            asm volatile("s_waitcnt vmcnt(0)" ::: "memory");
            const unsigned og = xb_add(&bar[XB_TOP], 1u);
            const unsigned tg = og / nx;
            if (og + 1u == (tg + 1u) * nx) xb_add(&bar[XB_TOPGEN], 1u);
            else XB_SPIN(xb_ld(&bar[XB_TOPGEN]) == tg, bar);
            __builtin_amdgcn_fence(__ATOMIC_ACQUIRE, "agent");
            xb_add(&bar[XB_XGEN(b.x)], 1u);
            asm volatile("s_waitcnt vmcnt(0)" ::: "memory");
        } else {
            XB_SPIN(xb_ld(&bar[XB_XGEN(b.x)]) == gen, bar);
            __builtin_amdgcn_fence(__ATOMIC_ACQUIRE, "agent");
            asm volatile("s_waitcnt vmcnt(0)" ::: "memory");
        }
    }
    __syncthreads();
}
typedef GAS unsigned gu32;
#define RLX_AGENT __ATOMIC_RELAXED, __HIP_MEMORY_SCOPE_AGENT
#define LDS_WAIT() asm volatile("s_waitcnt lgkmcnt(0)" ::: "memory")
__device__ __forceinline__ unsigned f2bf(float f) { unsigned u = __builtin_bit_cast(unsigned, f); return (u + 0x7fffu + ((u >> 16) & 1u)) >> 16; }
__device__ __forceinline__ unsigned pk2(float lo, float hi) { return f2bf(lo) | (f2bf(hi) << 16); }

__device__ __forceinline__ int t5_bucket(int rel) {
    const int ret = rel > 0 ? 16 : 0, n = rel < 0 ? -rel : rel; int v;
    if (n < 8) v = n; else if (n < 12) v = 8; else if (n < 16) v = 9; else if (n < 23) v = 10; else if (n < 32) v = 11;
    else if (n < 46) v = 12; else if (n < 64) v = 13; else if (n < 91) v = 14; else v = 15;
    return ret + v;
}

__device__ __forceinline__ void p0_transpose_item(const float* __restrict__ W, const float* __restrict__ gk, int K, int N, bf16_t* WT, int mode, LAS float* scr, int item, int lane) {
    const int nblk = (N + 31) / 32, kb = item / nblk, nb = item % nblk, k0 = 64 * kb, n0 = 32 * nb;
    const int nn = n0 + (lane & 31);
#pragma unroll 8
    for (int i = 0; i < 32; ++i) { const int kk = 2 * i + (lane >> 5); float v = 0.f; if (nn < N) v = W[(size_t)(k0 + kk) * N + nn]; if (gk) v *= gk[k0 + kk]; scr[kk * 33 + (lane & 31)] = v; }
    LDS_WAIT(); asm volatile("" ::: "memory");
    const int c = lane & 7;
#pragma unroll
    for (int j = 0; j < 4; ++j) { const int nl = (lane >> 3) + 8 * j, n = n0 + nl; const LAS float* s = scr + (8 * c) * 33 + nl;
        u32x4 o; o.x = pk2(s[0 * 33], s[1 * 33]); o.y = pk2(s[2 * 33], s[3 * 33]); o.z = pk2(s[4 * 33], s[5 * 33]); o.w = pk2(s[6 * 33], s[7 * 33]);
        int row = n; if (mode) row = 256 * (n >> 7) + (mode == 2 ? 128 : 0) + (n & 127);
        *(GAS u32x4*)(WT + (size_t)row * K + k0 + 8 * c) = o; }
    LDS_WAIT(); asm volatile("" ::: "memory");
}
struct P0Args { const float *x, *g_pre_mix, *w_in, *sgu_w, *rel_bias, *w_o, *g_pre_ffn, *w_gate, *w_up, *w_down;
                bf16_t *Win_t, *Wo_t, *Wgu_t, *Wd_t, *Ws, *XB; float *BTAB, *rstd1; };
__device__ __forceinline__ void p0_prologue(LAS unsigned char* lds, const P0Args& P, int vcu, int G, int tid, int wave, int lane) {
    LAS float* scr = (LAS float*)(lds + wave * 16384);
    const int gw = vcu * 8 + wave, NGW = G * 8;
    constexpr int I_IN = (DM / 64) * ((DIN + 31) / 32), I_O = (DM / 64) * (DM / 32), I_G = (DM / 64) * (DFF / 32), I_D = (DFF / 64) * (DM / 32);
    constexpr int NITEMS = I_IN + I_O + 2 * I_G + I_D;
    for (int it = gw; it < NITEMS; it += NGW) {
        int r = it;
        if (r < I_IN) { p0_transpose_item(P.w_in, P.g_pre_mix, DM, DIN, P.Win_t, 0, scr, r, lane); continue; } r -= I_IN;
        if (r < I_O) { p0_transpose_item(P.w_o, nullptr, DM, DM, P.Wo_t, 0, scr, r, lane); continue; } r -= I_O;
        if (r < I_G) { p0_transpose_item(P.w_gate, P.g_pre_ffn, DM, DFF, P.Wgu_t, 1, scr, r, lane); continue; } r -= I_G;
        if (r < I_G) { p0_transpose_item(P.w_up, P.g_pre_ffn, DM, DFF, P.Wgu_t, 2, scr, r, lane); continue; } r -= I_G;
        p0_transpose_item(P.w_down, nullptr, DFF, DM, P.Wd_t, 0, scr, r, lane);
    }
    const int gt = vcu * 512 + tid, NGT = G * 512;
    for (int i = gt; i < (DINP - 3168) * DM / 8; i += NGT) *(GAS u32x4*)(P.Win_t + (size_t)3168 * DM + (size_t)i * 8) = (u32x4){0u, 0u, 0u, 0u};
    for (int i = gt; i < 4 * 128 * 128; i += NGT) { const int ii = (i >> 7) & 127, j = i & 127; const float v = (ii < 64 && j >= 64) ? 0.f : P.sgu_w[i]; P.Ws[i] = (bf16_t)f2bf(v); }
    for (int i = gt; i < 4 * 256; i += NGT) { const int h = i >> 8, rel = (i & 255) - 192; P.BTAB[i] = (P.rel_bias[t5_bucket(rel) * 4 + h] - P.rel_bias[15 * 4 + h]) * (1.0f / ATT_SCALE); }
    for (int m = gw; m < NT; m += NGW) {
        const GAS f32x4* xr = (const GAS f32x4*)(P.x + (size_t)m * DM) + lane;
        f32x4 v[4]; float s = 0.f;
#pragma unroll
        for (int j = 0; j < 4; ++j) { v[j] = xr[64 * j]; s += (v[j].x * v[j].x + v[j].y * v[j].y) + (v[j].z * v[j].z + v[j].w * v[j].w); }
        s = wave_sum(s);
        GAS u32x2* o8 = (GAS u32x2*)(P.XB + (size_t)m * DM) + lane;
#pragma unroll
        for (int j = 0; j < 4; ++j) o8[64 * j] = (u32x2){cvt_pk_bf16(v[j].x, v[j].y), cvt_pk_bf16(v[j].z, v[j].w)};
        if (lane == 0) P.rstd1[m] = rsqrtf(s * (1.0f / DM) + EPS);
    }
}

struct SguArgs { const bf16_t *AU, *AV, *Ws; const float *ln_g, *ln_b, *sgu_b; bf16_t* MIXIN; };
__device__ __forceinline__ void sgu_block(LAS unsigned char* lds, const SguArgs& A, int blk, int tid, int wave, int lane) {
    constexpr int VROW = 272;
    LAS unsigned char* vnT = lds;
    LAS float* mu = (LAS float*)(lds + AUX_OFF); LAS float* rs = mu + 128;
    const size_t t0 = (size_t)blk * 128;
    for (int jj = 0; jj < 16; ++jj) {
        const int j = wave * 16 + jj;
        const u32x4 raw = *(const GAS u32x4*)(A.AV + (t0 + j) * DA + lane * 8);
        float f[8] = {bf_lo(raw.x), bf_hi(raw.x), bf_lo(raw.y), bf_hi(raw.y), bf_lo(raw.z), bf_hi(raw.z), bf_lo(raw.w), bf_hi(raw.w)};
        float s = 0.f;
#pragma unroll
        for (int e = 0; e < 8; ++e) s += f[e];
        const float mean = wave_sum(s) * (1.0f / DA);
        float q = 0.f;
#pragma unroll
        for (int e = 0; e < 8; ++e) { const float d = f[e] - mean; q += d * d; }
        const float var = wave_sum(q) * (1.0f / DA);
        if (lane == 0) { mu[j] = mean; rs[j] = rsqrtf(var + EPS); }
    }
    __syncthreads();
    const int it = wave & 3, ch = wave >> 2, kmax = (it < 2) ? 64 : 128;
    const int l31 = lane & 31, kh = lane >> 5;
    for (int g = 0; g < 4; ++g) {
        for (int idx = tid; idx < 128 * 16; idx += 512) {
            const int j = idx >> 4, chunk = idx & 15, col = g * 128 + chunk * 8;
            const u32x4 raw = *(const GAS u32x4*)(A.AV + (t0 + j) * DA + col);
            const float f[8] = {bf_lo(raw.x), bf_hi(raw.x), bf_lo(raw.y), bf_hi(raw.y), bf_lo(raw.z), bf_hi(raw.z), bf_lo(raw.w), bf_hi(raw.w)};
            const float m_ = mu[j], r_ = rs[j];
#pragma unroll
            for (int e = 0; e < 8; ++e) { const float v = (f[e] - m_) * r_ * A.ln_g[col + e] + A.ln_b[col + e];
                *(LAS bf16_t*)(vnT + (chunk * 8 + e) * VROW + j * 2) = (bf16_t)f2bf(v); }
        }
        __syncthreads();
        f32x16 acc[2] = {};
        for (int ks = 0; ks < kmax / 16; ++ks) {
            const bf16x8 a = *(const GAS bf16x8*)(A.Ws + ((size_t)g * 128 + 32 * it + l31) * 128 + ks * 16 + 8 * kh);
#pragma unroll
            for (int ct = 0; ct < 2; ++ct) {
                const bf16x8 b = *(const LAS bf16x8*)(vnT + (64 * ch + 32 * ct + l31) * VROW + (ks * 16 + 8 * kh) * 2);
                acc[ct] = __builtin_amdgcn_mfma_f32_32x32x16_bf16(a, b, acc[ct], 0, 0, 0);
            }
        }
#pragma unroll
        for (int ct = 0; ct < 2; ++ct)
#pragma unroll
            for (int r = 0; r < 16; ++r) {
                const int i = 32 * it + (r & 3) + 8 * (r >> 2) + 4 * kh, col = g * 128 + 64 * ch + 32 * ct + l31;
                const float mixed = acc[ct][r] + A.sgu_b[g * 128 + i];
                const float au = __uint_as_float((unsigned)A.AU[(t0 + i) * DA + col] << 16);
                A.MIXIN[(t0 + i) * DM + col] = (bf16_t)f2bf(au * mixed);
            }
        __syncthreads();
    }
}

__device__ __forceinline__ int cnt_ge(const float (&s)[64], float t, int nreg) {
    int c = 0;
#pragma unroll
    for (int gq = 0; gq < 4; ++gq) if (nreg > 16 * gq) {
#pragma unroll
        for (int j = 16 * gq; j < 16 * gq + 16; ++j) c += __popcll(__ballot(s[j] >= t));
    }
    return c;
}
__device__ __forceinline__ int cnt_gt(const float (&s)[64], float t, int nreg) {
    int c = 0;
#pragma unroll
    for (int gq = 0; gq < 4; ++gq) if (nreg > 16 * gq) {
#pragma unroll
        for (int j = 16 * gq; j < 16 * gq + 16; ++j) c += __popcll(__ballot(s[j] > t));
    }
    return c;
}
struct SelArgs { const bf16_t *IQ, *IK; const float* IW; unsigned long long* MASK; };
__device__ __forceinline__ void select_job(LAS unsigned char* lds, const SelArgs& A, int b, int qb32, int tid, int wave, int lane) {
    LAS float* sc = (LAS float*)lds;
    LAS float* thr = (LAS float*)(lds + AUX_OFF + 2048);
    const int c = qb32 >> 1, nvis = 64 * (c + 1), ntile32 = nvis >> 5, ntile64 = c + 1;
    GAS unsigned char* mbase = (GAS unsigned char*)(A.MASK + ((size_t)(b * 128 + qb32) * 64) * 32);
    const int i31 = lane & 31, kh = lane >> 5;
    for (int u = 0; u < 4; ++u) {
        const int tb = b * SEQ + qb32 * 32 + u * 8;
        if (nvis > TOPK) {
            const int hd = (i31 & 3) + 4 * ((i31 >> 3) & 1), qs = 2 * (i31 >> 4) + ((i31 >> 2) & 1);
            bf16x8 Af[2][4]; float cf[2][16];
#pragma unroll
            for (int rho = 0; rho < 2; ++rho) {
#pragma unroll
                for (int kk = 0; kk < 4; ++kk) Af[rho][kk] = *(const GAS bf16x8*)(A.IQ + (size_t)(tb + 4 * rho + qs) * 512 + hd * 64 + kk * 16 + 8 * kh);
#pragma unroll
                for (int j = 0; j < 2; ++j) { const GAS f32x4* wp = (const GAS f32x4*)(A.IW + (size_t)(tb + 4 * rho + 2 * j + kh) * 8); const f32x4 w0 = wp[0], w1 = wp[1];
#pragma unroll
                    for (int e = 0; e < 4; ++e) { cf[rho][8 * j + e] = w0[e] * IDX_COEF; cf[rho][8 * j + 4 + e] = w1[e] * IDX_COEF; } }
            }
            for (int tau = wave; tau < ntile32; tau += 8) {
                const bf16_t* kp = A.IK + (size_t)(b * SEQ + tau * 32 + i31) * 64 + 8 * kh;
                bf16x8 Bf[4];
#pragma unroll
                for (int kk = 0; kk < 4; ++kk) Bf[kk] = *(const GAS bf16x8*)(kp + kk * 16);
#pragma unroll
                for (int rho = 0; rho < 2; ++rho) {
                    f32x16 acc = {};
#pragma unroll
                    for (int kk = 0; kk < 4; ++kk) acc = __builtin_amdgcn_mfma_f32_32x32x16_bf16(Af[rho][kk], Bf[kk], acc, 0, 0, 0);
                    float s0 = 0.f, s1 = 0.f;
#pragma unroll
                    for (int e = 0; e < 8; ++e) { s0 += cf[rho][e] * fmaxf(acc[e], 0.f); s1 += cf[rho][8 + e] * fmaxf(acc[8 + e], 0.f); }
                    sc[(4 * rho + kh) * 4096 + tau * 32 + i31] = s0;
                    sc[(4 * rho + 2 + kh) * 4096 + tau * 32 + i31] = s1;
                }
            }
            __syncthreads();
            {
                LAS float* row = sc + wave * 4096;
                const int nreg = nvis >> 6;
                const float PINF = __builtin_inff();
                float s[64];
#pragma unroll
                for (int j = 0; j < 64; ++j) s[j] = (j < nreg) ? row[j * 64 + lane] : -PINF;
                float mn = PINF, mx = -PINF;
#pragma unroll
                for (int j = 0; j < 64; ++j) { mx = fmaxf(mx, s[j]); mn = fminf(mn, (j < nreg) ? s[j] : PINF); }
#pragma unroll
                for (int o = 1; o < 64; o <<= 1) { mx = fmaxf(mx, __shfl_xor(mx, o)); mn = fminf(mn, __shfl_xor(mn, o)); }
                float thr_v = mx, tie_v = 0.f; int need = 0;
                const int cmx = cnt_ge(s, mx, nreg);
                if (cmx >= TOPK) { if (cmx > TOPK) { tie_v = mx; need = TOPK; thr_v = PINF; } }
                else {
                    const int c0 = cnt_ge(s, 0.f, nreg), cp = cnt_gt(s, 0.f, nreg);
                    if (cp < TOPK && c0 >= TOPK) { thr_v = 0.f; if (c0 > TOPK) { tie_v = 0.f; need = TOPK - cp; thr_v = __uint_as_float(1u); } }
                    else {
                        float lo = mn, hi = mx; int chi = cmx;
                        for (;;) {
                            const float mid = 0.5f * lo + 0.5f * hi;
                            if (!(mid > lo && mid < hi)) { tie_v = lo; need = TOPK - chi; thr_v = hi; break; }
                            const int cm = cnt_ge(s, mid, nreg);
                            if (cm == TOPK) { thr_v = mid; break; }
                            if (cm > TOPK) lo = mid; else { hi = mid; chi = cm; }
                        }
                    }
                }
                if (need > 0) {
                    int base = 0;
#pragma unroll
                    for (int j = 0; j < 64; ++j) {
                        const bool eq = (j < nreg) && (s[j] == tie_v);
                        const unsigned long long m = __ballot(eq);
                        if (m) { const int rank = base + (int)__builtin_amdgcn_mbcnt_hi((unsigned)(m >> 32), __builtin_amdgcn_mbcnt_lo((unsigned)m, 0u));
                                 if (eq && rank < need) row[j * 64 + lane] = PINF;
                                 base += __popcll(m); }
                    }
                }
                if (lane == 0) thr[wave] = thr_v;
            }
            __syncthreads();
        }
        for (int kt = wave; kt < ntile64; kt += 8) {
            unsigned byte = 0xFFu;
            if (nvis > TOPK) { byte = 0u;
#pragma unroll
                for (int q = 0; q < 8; ++q) byte |= (sc[q * 4096 + kt * 64 + lane] >= thr[q]) ? (1u << q) : 0u; }
            const int p = lane >> 5, r = (lane & 3) | (((lane >> 3) & 3) << 2), hh = (lane >> 2) & 1;
            mbase[(size_t)kt * 256 + (p * 16 + r) * 8 + hh * 4 + u] = (unsigned char)byte;
        }
        __syncthreads();
    }
}

template <bool FIRST>
__device__ __forceinline__ void resid_phase(const float* base, const bf16_t* raw, const float* ssp, const float* __restrict__ g, float* out, bf16_t* X1B, float* rstd3, int vcu, int G, int wave, int lane) {
    const int gw = vcu * 8 + wave, NGW = G * 8;
    f32x4 gv[4];
#pragma unroll
    for (int j = 0; j < 4; ++j) gv[j] = *(const f32x4*)(g + 4 * lane + 256 * j);
    for (int m = gw; m < NT; m += NGW) {
        float p = lane < 16 ? ssp[(size_t)m * 16 + lane] : 0.f;
        const float rstd = rsqrtf(wave_sum(p) * (1.0f / DM) + EPS);
        const GAS f32x4* xr = (const GAS f32x4*)(base + (size_t)m * DM) + lane;
        const GAS u32x2* rr = (const GAS u32x2*)(raw + (size_t)m * DM) + lane;
        GAS f32x4* orow = (GAS f32x4*)(out + (size_t)m * DM) + lane;
        float q = 0.f;
#pragma unroll
        for (int j = 0; j < 4; ++j) {
            const f32x4 xv = xr[64 * j]; const u32x2 rw = rr[64 * j];
            f32x4 y;
            y.x = xv.x + bf_lo(rw.x) * rstd * gv[j].x; y.y = xv.y + bf_hi(rw.x) * rstd * gv[j].y;
            y.z = xv.z + bf_lo(rw.y) * rstd * gv[j].z; y.w = xv.w + bf_hi(rw.y) * rstd * gv[j].w;
            orow[64 * j] = y;
            if (FIRST) { q += (y.x * y.x + y.y * y.y) + (y.z * y.z + y.w * y.w);
                ((GAS u32x2*)(X1B + (size_t)m * DM) + lane)[64 * j] = (u32x2){cvt_pk_bf16(y.x, y.y), cvt_pk_bf16(y.z, y.w)}; }
        }
        if (FIRST) { q = wave_sum(q); if (lane == 0) rstd3[m] = rsqrtf(q * (1.0f / DM) + EPS); }
    }
}
constexpr int NWAVES = 8, PER_PHASE = 9;
constexpr int CW_BAR = 4096;
static_assert((CW_BAR + XCD_BAR_WORDS) * 4 <= (int)CTL_ZERO_BYTES, "barrier words inside the memset region");
struct Args { const float* in[15]; float* out; unsigned char* ws; int ph_lo, ph_hi, li, pad; };

__global__ void __launch_bounds__(NWAVES * 64, 2) mk_fwd(Args args) {
    extern __shared__ __attribute__((aligned(16))) unsigned char lds_raw[];
    LAS unsigned char* lds = (LAS unsigned char*)lds_raw;
    volatile LAS unsigned* MISC = (volatile LAS unsigned*)(lds + MISC_OFF);
    const int tid = threadIdx.x, lane = tid & 63, wave = __builtin_amdgcn_readfirstlane(tid >> 6);
    const int G = gridDim.x, bx = blockIdx.x, vcu = (G % 8 == 0) ? (bx % 8) * (G / 8) + bx / 8 : bx;
    unsigned char* ws = args.ws;
    const float* x = args.in[0]; const float* g_pre_mix = args.in[1]; const float* w_in = args.in[2]; const float* sgu_ln_g = args.in[3]; const float* sgu_ln_b = args.in[4];
    const float* sgu_w = args.in[5]; const float* sgu_b = args.in[6]; const float* rel_bias = args.in[7]; const float* w_o = args.in[8]; const float* g_post_mix = args.in[9];
    const float* g_pre_ffn = args.in[10]; const float* w_gate = args.in[11]; const float* w_up = args.in[12]; const float* w_down = args.in[13]; const float* g_post_ffn = args.in[14];
    float* out = args.out;
    bf16_t* Win_t = (bf16_t*)(ws + WS_WIN); bf16_t* Wo_t = (bf16_t*)(ws + WS_WO); bf16_t* Wgu_t = (bf16_t*)(ws + WS_WGU); bf16_t* Wd_t = (bf16_t*)(ws + WS_WD); bf16_t* Wsb = (bf16_t*)(ws + WS_WS);
    float* BTAB = (float*)(ws + WS_BTAB); float* rstd1 = (float*)(ws + WS_RSTD1); float* rstd3 = (float*)(ws + WS_RSTD3); float* SSP = (float*)(ws + WS_SSP); float* IW = (float*)(ws + WS_IW);
    bf16_t* XB = (bf16_t*)(ws + WS_XB); bf16_t* AU = (bf16_t*)(ws + WS_AU); bf16_t* AV = (bf16_t*)(ws + WS_AV); bf16_t* Qb = (bf16_t*)(ws + WS_Q); bf16_t* Kb = (bf16_t*)(ws + WS_K); bf16_t* Vb = (bf16_t*)(ws + WS_V);
    bf16_t* IQ = (bf16_t*)(ws + WS_IQ); bf16_t* IK = (bf16_t*)(ws + WS_IK); unsigned long long* MASK = (unsigned long long*)(ws + WS_MASK);
    bf16_t* MIXIN = (bf16_t*)(ws + WS_MIXIN); bf16_t* MIXRAW = (bf16_t*)(ws + WS_MIXRAW); bf16_t* X1B = (bf16_t*)(ws + WS_X1B); bf16_t* HMID = (bf16_t*)(ws + WS_HMID); bf16_t* FRAW = (bf16_t*)(ws + WS_FRAW);

    for (int u = tid; u < (LDS_BYTES - LDSCTL_OFF) / 4; u += NWAVES * 64) ((LAS unsigned*)(lds + LDSCTL_OFF))[u] = 0u;
    __syncthreads();
    XcdBarrier bar; bar.bar = (unsigned*)(ws + WS_CTL) + CW_BAR; bar.x = 0; bar.st = nullptr;
    if (!MK_PER_PHASE) bar = xcd_barrier_post((unsigned*)(ws + WS_CTL) + CW_BAR, MISC + 8);
    const int lo = args.ph_lo, hi = args.ph_hi;
#define IN(k) (lo <= (k) && (k) < hi)
#define SEAM(k) do { if (IN(k) && IN((k) + 1)) xcd_barrier(bar); } while (0)

    if (IN(0)) {
        P0Args P{x, g_pre_mix, w_in, sgu_w, rel_bias, w_o, g_pre_ffn, w_gate, w_up, w_down, Win_t, Wo_t, Wgu_t, Wd_t, Wsb, XB, BTAB, rstd1};
        p0_prologue(lds, P, vcu, G, tid, wave, lane);
        SEAM(0);
    }
    if (IN(1)) {
        pg8::Gemm g{XB, Win_t, NT, DINP, DM}; pg8::StaticOrder S; S.init(NT, DINP, G, bx);
        pg8::EpiProj E{rstd1, AU, AV, Qb, Kb, Vb, IQ, IK, IW};
        pg8::gemm_phase<pg8::EpiProj, pg8::StaticOrder, true, true>(lds, g, S, E);
        SEAM(1);
    }
    if (IN(2)) {
        SguArgs SA{AU, AV, Wsb, sgu_ln_g, sgu_ln_b, sgu_b, MIXIN};
        for (int blk = vcu; blk < NT / 128; blk += G) sgu_block(lds, SA, blk, tid, wave, lane);
        SelArgs SE{IQ, IK, IW, MASK};
        for (int pi = vcu; pi < 512; pi += G) {
            const int b = pi >> 6, p = pi & 63;
            select_job(lds, SE, b, p, tid, wave, lane);
            select_job(lds, SE, b, 127 - p, tid, wave, lane);
        }
        SEAM(2);
    }
    if (IN(3)) {
        att::AttnArgs AA{(const __hip_bfloat16*)Qb, (const __hip_bfloat16*)Kb, (const __hip_bfloat16*)Vb, (__hip_bfloat16*)MIXIN, MASK, BTAB};
        att::attn_phase((char*)lds_raw, AA, vcu, G);
        SEAM(3);
    }
    if (IN(4)) {
        pg8::Gemm g{MIXIN, Wo_t, NT, DM, DM}; pg8::StaticOrder S; S.init(NT, DM, G, bx);
        pg8::EpiRaw E{MIXRAW, SSP};
        pg8::gemm_phase<pg8::EpiRaw, pg8::StaticOrder, true, true>(lds, g, S, E);
        SEAM(4);
    }
    if (IN(5)) { resid_phase<true>(x, MIXRAW, SSP, g_post_mix, out, X1B, rstd3, vcu, G, wave, lane); SEAM(5); }
    if (IN(6)) {
        pg8::Gemm g{X1B, Wgu_t, NT, 2 * DFF, DM}; pg8::StaticOrder S; S.init(NT, 2 * DFF, G, bx);
        pg8::EpiSwiGLU E{HMID, rstd3};
        pg8::gemm_phase<pg8::EpiSwiGLU, pg8::StaticOrder, true, true>(lds, g, S, E);
        SEAM(6);
    }
    if (IN(7)) {
        pg8::Gemm g{HMID, Wd_t, NT, DM, DFF}; pg8::StaticOrder S; S.init(NT, DM, G, bx);
        pg8::EpiRaw E{FRAW, SSP};
        pg8::gemm_phase<pg8::EpiRaw, pg8::StaticOrder, true, true>(lds, g, S, E);
        SEAM(7);
    }
    if (IN(8)) resid_phase<false>(out, FRAW, SSP, g_post_ffn, out, nullptr, nullptr, vcu, G, wave, lane);
#undef IN
#undef SEAM
}

extern "C" void kernel_launch(void* const* d_in, const int* in_sizes, int n_in, void* d_out, int out_size, void* d_ws, size_t ws_size, hipStream_t stream) {
    static int grid = 0;
    if (grid == 0) {
        if (n_in != 15 || in_sizes[0] != NT * DM || out_size != NT * DM || ws_size < WS_END) { fprintf(stderr, "kernel_launch: unexpected shapes (n_in %d, in0 %d, out %d, ws %zu); nothing launched\n", n_in, n_in > 0 ? in_sizes[0] : -1, out_size, ws_size); grid = -1; return; }
        int dev = 0, cus = 0, per_cu = 0;
        if (hipGetDevice(&dev) != hipSuccess || hipDeviceGetAttribute(&cus, hipDeviceAttributeMultiprocessorCount, dev) != hipSuccess) { grid = -1; return; }
        if (hipFuncSetAttribute((const void*)mk_fwd, hipFuncAttributeMaxDynamicSharedMemorySize, LDS_BYTES) != hipSuccess) { fprintf(stderr, "kernel_launch: hipFuncSetAttribute failed\n"); grid = -1; return; }
        if (hipOccupancyMaxActiveBlocksPerMultiprocessor(&per_cu, (const void*)mk_fwd, NWAVES * 64, LDS_BYTES) != hipSuccess || per_cu < 1)
            fprintf(stderr, "kernel_launch: note: occupancy query reports %d workgroups per CU\n", per_cu);
        (void)hipGetLastError();
        grid = cus;
    }
    if (grid < 0) return;
    if (hipMemsetAsync((char*)d_ws + WS_CTL, 0, CTL_ZERO_BYTES, stream) != hipSuccess) return;
    Args a{};
    for (int i = 0; i < 15; ++i) a.in[i] = (const float*)d_in[i];
    a.out = (float*)d_out; a.ws = (unsigned char*)d_ws;
#if MK_PER_PHASE
    for (int li = 0; li < PER_PHASE; ++li) { a.ph_lo = li; a.ph_hi = li + 1; a.li = li; hipLaunchKernelGGL(mk_fwd, dim3(grid), dim3(NWAVES * 64), LDS_BYTES, stream, a); }
#else
    a.ph_lo = 0; a.ph_hi = PER_PHASE; a.li = 0;
    hipLaunchKernelGGL(mk_fwd, dim3(grid), dim3(NWAVES * 64), LDS_BYTES, stream, a);
#endif
}
```
